# Optimizing an MI355X kernel written in HIP

```python
import math
import jax, jax.numpy as jnp
from jax import lax
import numpy as np

D_MODEL = 1024
BATCH = 8
SEQ = 4096
DEPTH = 2

N_META = 16
Q_BLOCK = 128
SB_HEADS = 8
SB_HEAD_DIM = 64
SB_WIDTH = SB_HEADS * SB_HEAD_DIM
MLA_HEADS = 8
MLA_NOPE = 64
MLA_ROPE = 32
MLA_V = 64
Q_LORA = 384
KV_LORA = 256
MLA_WIDTH = MLA_HEADS * MLA_V
MIX_WIDTH = SB_WIDTH + MLA_WIDTH
IN_COLS = 3 * SB_WIDTH + Q_LORA + KV_LORA + MLA_ROPE
D_FF = -(-8 * D_MODEL // (3 * 256)) * 256
ROPE_THETA = 10000.0
EPS = 1e-6

kernel_name = "hybrid_stickbreaking_mla_block"


def rms_norm(x, gain):
    xf = x.astype(jnp.float32)
    y = xf * lax.rsqrt(jnp.mean(xf * xf, axis=-1, keepdims=True) + EPS)
    return y.astype(x.dtype) * gain.astype(x.dtype)


def rope_tables(length):
    inv_freq = 1.0 / (ROPE_THETA ** (jnp.arange(0, MLA_ROPE, 2, dtype=jnp.float32) / MLA_ROPE))
    ang = jnp.arange(length, dtype=jnp.float32)[:, None] * inv_freq[None, :]
    return jnp.cos(ang), jnp.sin(ang)


def apply_rope(x, cos, sin):
    xf = x.astype(jnp.float32)
    half = MLA_ROPE // 2
    x1, x2 = xf[..., :half], xf[..., half:]
    c = cos[None, :, None, :]
    s = sin[None, :, None, :]
    return jnp.concatenate([x1 * c - x2 * s, x2 * c + x1 * s], axis=-1).astype(x.dtype)


def stick_breaking_block(q, k, v, q_start):
    scale = 1.0 / math.sqrt(SB_HEAD_DIM)
    z = jnp.einsum('bqhd,bkhd->bhqk', q.astype(jnp.float32), k.astype(jnp.float32)) * scale
    t_idx = q_start + jnp.arange(q.shape[1])
    s_idx = jnp.arange(k.shape[1])
    causal = s_idx[None, :] < t_idx[:, None]
    log_1m = jnp.where(causal, jax.nn.log_sigmoid(-z), 0.0)
    suffix = lax.cumsum(log_1m, axis=3, reverse=True) - log_1m
    a = jnp.where(causal, jnp.exp(jax.nn.log_sigmoid(z) + suffix), 0.0)
    o = jnp.einsum('bhqk,bkhd->bqhd', a, v.astype(jnp.float32))
    return o.astype(v.dtype)


def mla_block(q, k, v, q_start):
    scale = 1.0 / math.sqrt(MLA_NOPE + MLA_ROPE)
    s = jnp.einsum('bqhd,bkhd->bhqk', q.astype(jnp.float32), k.astype(jnp.float32)) * scale
    t_idx = q_start + jnp.arange(q.shape[1])
    s_idx = jnp.arange(k.shape[1])
    causal = s_idx[None, :] <= t_idx[:, None]
    s = jnp.where(causal, s, jnp.finfo(jnp.float32).min)
    p = jax.nn.softmax(s, axis=-1)
    o = jnp.einsum('bhqk,bkhd->bqhd', p, v.astype(jnp.float32))
    return o.astype(v.dtype)


def setup_inputs(seed: int = 0) -> dict:
    key = jax.random.key(seed)
    ks = jax.random.split(key, 20)
    f32 = jnp.float32

    def w(k, shape, fan_in):
        return jax.random.normal(k, shape, f32) * (fan_in ** -0.5)

    def gain(k, shape):
        return 1.0 + 0.05 * jax.random.normal(k, shape, f32)

    return {
        "x": jax.random.normal(ks[0], (BATCH, SEQ, D_MODEL), f32),
        "meta_tokens": jax.random.normal(ks[1], (N_META, D_MODEL), f32),
        "w_in": w(ks[2], (DEPTH, D_MODEL, IN_COLS), D_MODEL),
        "q_lat_norm": gain(ks[3], (DEPTH, Q_LORA)),
        "kv_lat_norm": gain(ks[4], (DEPTH, KV_LORA)),
        "w_uq": w(ks[5], (DEPTH, Q_LORA, MLA_HEADS * (MLA_NOPE + MLA_ROPE)), Q_LORA),
        "w_ukv": w(ks[6], (DEPTH, KV_LORA, MLA_HEADS * (MLA_NOPE + MLA_V)), KV_LORA),
        "sb_out_norm": gain(ks[7], (DEPTH, SB_WIDTH)),
        "mla_out_norm": gain(ks[8], (DEPTH, MLA_WIDTH)),
        "w_o": w(ks[9], (DEPTH, MIX_WIDTH, D_MODEL), MIX_WIDTH),
        "pre_mix_norm": gain(ks[10], (DEPTH, D_MODEL)),
        "post_mix_norm": gain(ks[11], (DEPTH, D_MODEL)),
        "pre_ffn_norm": gain(ks[12], (DEPTH, D_MODEL)),
        "post_ffn_norm": gain(ks[13], (DEPTH, D_MODEL)),
        "w_gate": w(ks[14], (DEPTH, D_MODEL, D_FF), D_MODEL),
        "w_up": w(ks[15], (DEPTH, D_MODEL, D_FF), D_MODEL),
        "w_down": w(ks[16], (DEPTH, D_FF, D_MODEL), D_FF),
    }


def reference(x, meta_tokens, w_in, q_lat_norm, kv_lat_norm, w_uq, w_ukv, sb_out_norm, mla_out_norm,
              w_o, pre_mix_norm, post_mix_norm, pre_ffn_norm, post_ffn_norm, w_gate, w_up, w_down):
    B = x.shape[0]
    n_real = x.shape[1]
    meta = jnp.broadcast_to(meta_tokens.astype(x.dtype)[None], (B, N_META, D_MODEL))
    h = jnp.concatenate([meta, x], axis=1)
    L = h.shape[1]
    cos, sin = rope_tables(L)
    blocks = [(0, N_META)] + [(N_META + i * Q_BLOCK, N_META + (i + 1) * Q_BLOCK)
                              for i in range(n_real // Q_BLOCK)]
    o1 = 3 * SB_WIDTH
    o2 = o1 + Q_LORA
    o3 = o2 + KV_LORA

    for layer in range(DEPTH):
        u = rms_norm(h, pre_mix_norm[layer])
        proj = jnp.einsum('bld,dc->blc', u, w_in[layer])
        q_sb = proj[..., 0:SB_WIDTH].reshape(B, L, SB_HEADS, SB_HEAD_DIM)
        k_sb = proj[..., SB_WIDTH:2 * SB_WIDTH].reshape(B, L, SB_HEADS, SB_HEAD_DIM)
        v_sb = proj[..., 2 * SB_WIDTH:o1].reshape(B, L, SB_HEADS, SB_HEAD_DIM)
        c_q = rms_norm(proj[..., o1:o2], q_lat_norm[layer])
        c_kv = rms_norm(proj[..., o2:o3], kv_lat_norm[layer])
        k_rope = proj[..., o3:].reshape(B, L, 1, MLA_ROPE)

        q_m = jnp.einsum('blr,rc->blc', c_q, w_uq[layer]).reshape(B, L, MLA_HEADS, MLA_NOPE + MLA_ROPE)
        kv_m = jnp.einsum('blr,rc->blc', c_kv, w_ukv[layer]).reshape(B, L, MLA_HEADS, MLA_NOPE + MLA_V)
        q_mla = jnp.concatenate([q_m[..., :MLA_NOPE], apply_rope(q_m[..., MLA_NOPE:], cos, sin)], axis=-1)
        k_rope_r = jnp.broadcast_to(apply_rope(k_rope, cos, sin), (B, L, MLA_HEADS, MLA_ROPE))
        k_mla = jnp.concatenate([kv_m[..., :MLA_NOPE], k_rope_r], axis=-1)
        v_mla = kv_m[..., MLA_NOPE:]

        o_sb = jnp.concatenate([stick_breaking_block(q_sb[:, s:e], k_sb[:, :e], v_sb[:, :e], s)
                                for (s, e) in blocks], axis=1)
        o_mla = jnp.concatenate([mla_block(q_mla[:, s:e], k_mla[:, :e], v_mla[:, :e], s)
                                 for (s, e) in blocks], axis=1)

        merged = jnp.concatenate([rms_norm(o_sb.reshape(B, L, SB_WIDTH), sb_out_norm[layer]),
                                  rms_norm(o_mla.reshape(B, L, MLA_WIDTH), mla_out_norm[layer])], axis=-1)
        mix = jnp.einsum('blc,cd->bld', merged, w_o[layer])
        h = h + rms_norm(mix, post_mix_norm[layer])

        f = rms_norm(h, pre_ffn_norm[layer])
        g = jnp.einsum('bld,df->blf', f, w_gate[layer])
        up = jnp.einsum('bld,df->blf', f, w_up[layer])
        ffn = jnp.einsum('blf,fd->bld', jax.nn.silu(g) * up, w_down[layer])
        h = h + rms_norm(ffn, post_ffn_norm[layer])

    return h[:, N_META:]
```

```cpp
#include <hip/hip_runtime.h>
#include <hip/hip_cooperative_groups.h>
#include <cstdio>
#include <cstdint>
#include <cmath>
#include <cstring>
namespace cg = cooperative_groups;

__device__ __forceinline__ int phase_tid(int wave_s) { int lane; asm volatile("v_mbcnt_lo_u32_b32 %0, -1, 0\n\tv_mbcnt_hi_u32_b32 %0, -1, %0" : "=v"(lane)); return wave_s * 64 + lane; }

namespace pg8 {
#define PG8_LAS __attribute__((address_space(3)))
typedef unsigned short bf16_t;
typedef short bf16x8 __attribute__((ext_vector_type(8)));
typedef float f32x4 __attribute__((ext_vector_type(4)));
typedef unsigned u32x4 __attribute__((ext_vector_type(4)));
constexpr int BM = 256, BK = 64, HALF = 128, HTB = HALF * BK * 2  , STAGE_BYTES = 8 * HTB, NXCD = 8, WGM = 8;

__host__ __device__ __forceinline__ int lds_byte(int r, int c) { const int st = (r >> 4) * 2 + (c >> 5), rr = r & 15, cc = c & 31, ob = rr * 64 + cc * 2; return st * 1024 + (ob ^ (((ob >> 9) & 1) << 5)); }
__host__ __device__ __forceinline__ void stage_rc(int b, int& R, int& C) { const int st = b / 1024, sb = b % 1024, swz = sb ^ (((sb >> 9) & 1) << 5); R = (st >> 1) * 16 + swz / 64; C = (st & 1) * 32 + (swz % 64) / 2; }
__host__ __device__ __forceinline__ int perm32(int rho) { const int n = rho >> 4, i = rho & 15; return 8 * (i >> 2) + 4 * n + (i & 3); }

struct Unit { int pm, pn; };
struct Gemm { const bf16_t* A; const bf16_t* Bt; int M, N, K, lda, ldb, kmid; };

struct StaticOrder {
    int nM, nN, nwg, G, c;
    __host__ __device__ void init(int M, int N, int G_, int c_) { nM = M / BM; nN = N / BM; nwg = nM * nN; G = G_; c = c_; }
    __host__ __device__ bool next(int i, Unit& u) const {
        const long L = (long)i * G + c; if (L >= nwg) return false;
        int wgid = (int)L; { const int q = nwg / NXCD, r = nwg % NXCD, xcd = wgid % NXCD, off = wgid / NXCD; wgid = (xcd < r ? xcd * (q + 1) : r * (q + 1) + (xcd - r) * q) + off; }
        const int nig = WGM * nN, gid = wgid / nig, fm = gid * WGM, gsz = (nM - fm) < WGM ? (nM - fm) : WGM;
        u.pm = fm + ((wgid % nig) % gsz); u.pn = (wgid % nig) / gsz; return true;
    }
    __device__ __forceinline__ void a_ready(const Unit&) const {}
    __device__ __forceinline__ void done(const Unit&) const {}
};


template <class Epi, class Sched, bool ALIGN_EPI = false, bool SP2 = false>
__device__ __forceinline__ void gemm_phase(PG8_LAS unsigned char* lds, const Gemm g, const Sched& S, const Epi& E, const int wave_s) {
    int tid_ = phase_tid(wave_s);
    const int tid = tid_, wid = __builtin_amdgcn_readfirstlane(tid >> 6), lane = tid & 63, wr = wid >> 2, wc = wid & 3, fr = lane & 15, fq = lane >> 4;
    const int K = g.K, nt = K / BK;
    unsigned voffA[2], voffB[2];
#pragma unroll
    for (int i = 0; i < 2; ++i) { int R, C; stage_rc(tid * 16 + i * 8192, R, C); const int Rb = Epi::PERM ? ((R & ~31) + perm32(R & 31)) : R;
        voffA[i] = (unsigned)(R * g.lda + C) * 2u; voffB[i] = (unsigned)(Rb * g.ldb + C) * 2u; }
    const size_t kstep = (size_t)(BK * 2);
    const size_t hstepA = (size_t)HALF * g.lda * 2, hstepB = (size_t)HALF * g.ldb * 2;
    const size_t tstepA = 2 * hstepA, tstepB = 2 * hstepB;
    const unsigned ldsw = (unsigned)wid * 1024u;
    const int aoff = lds_byte(wr * 64 + fr, fq * 8), boff = lds_byte(wc * 32 + fr, fq * 8);
#define PG8_SA(b, h) (((b) * 2 + (h)) * HTB)
#define PG8_SB(b, h) ((4 + (b) * 2 + (h)) * HTB)
#define PG8_STAGE(bufoff, gbase, voff) do { _Pragma("unroll") for (int _i = 0; _i < 2; ++_i) \
        __builtin_amdgcn_global_load_lds((const unsigned*)((const char*)(gbase) + (voff)[_i]), (PG8_LAS unsigned*)(lds + (bufoff) + ldsw + _i * 8192), 16, 0, 0); } while (0)
#define PG8_LDA(dst, b, h) do { _Pragma("unroll") for (int m = 0; m < 4; ++m) _Pragma("unroll") for (int k = 0; k < 2; ++k) dst[m][k] = *(const PG8_LAS bf16x8*)(lds + PG8_SA(b, h) + aoff + m * 2048 + k * 1024); } while (0)
#define PG8_LDB(dst, b, h) do { _Pragma("unroll") for (int n = 0; n < 2; ++n) _Pragma("unroll") for (int k = 0; k < 2; ++k) dst[n][k] = *(const PG8_LAS bf16x8*)(lds + PG8_SB(b, h) + boff + n * 2048 + k * 1024); } while (0)
#define PG8_MMA(ai, bj, At, Bt) do { __builtin_amdgcn_s_setprio(1); _Pragma("unroll") for (int m = 0; m < 4; ++m) _Pragma("unroll") for (int n = 0; n < 2; ++n) _Pragma("unroll") for (int k = 0; k < 2; ++k) \
        acc[ai][bj][m][n] = __builtin_amdgcn_mfma_f32_16x16x32_bf16(Bt[n][k], At[m][k], acc[ai][bj][m][n], 0, 0, 0); __builtin_amdgcn_s_setprio(0); } while (0)
#define PG8_WAIT_V(n) asm volatile("s_waitcnt vmcnt(" #n ")" ::: "memory")
#define PG8_WAIT_L(n) asm volatile("s_waitcnt lgkmcnt(" #n ")" ::: "memory")
#define PG8_BAR __builtin_amdgcn_s_barrier()
#define PG8_SCHED __builtin_amdgcn_sched_barrier(0)
    Unit cur, nxt; int ui = 0;
    if (!S.next(0, cur)) return;
    f32x4 acc[2][2][4][2];
#pragma unroll
    for (int a = 0; a < 2; ++a)
#pragma unroll
        for (int b = 0; b < 2; ++b)
#pragma unroll
            for (int m = 0; m < 4; ++m)
#pragma unroll
                for (int n = 0; n < 2; ++n) acc[a][b][m][n] = (f32x4){0.f, 0.f, 0.f, 0.f};
    bf16x8 At[4][2], B0[2][2], B1[2][2];
    const char* cA = (const char*)g.A + (size_t)cur.pm * tstepA; const char* cB = (const char*)g.Bt + (size_t)cur.pn * tstepB;
    S.a_ready(cur);
    if constexpr (SP2) {
        PG8_STAGE(PG8_SB(0, 0), cB, voffB); PG8_STAGE(PG8_SB(0, 1), cB + hstepB, voffB); PG8_STAGE(PG8_SA(0, 0), cA, voffA); PG8_STAGE(PG8_SA(0, 1), cA + hstepA, voffA);
        if (wr == 1) PG8_BAR;
        PG8_WAIT_V(2); PG8_BAR;
        PG8_STAGE(PG8_SB(1, 0), cB + kstep, voffB); PG8_STAGE(PG8_SA(1, 0), cA + kstep, voffA); PG8_STAGE(PG8_SB(1, 1), cB + hstepB + kstep, voffB);
        PG8_WAIT_V(6); PG8_BAR;
    } else {
        PG8_STAGE(PG8_SB(0, 0), cB, voffB); PG8_STAGE(PG8_SA(0, 0), cA, voffA); PG8_STAGE(PG8_SB(0, 1), cB + hstepB, voffB); PG8_STAGE(PG8_SA(0, 1), cA + hstepA, voffA);
        if (wr == 1) PG8_BAR;
        PG8_WAIT_V(4); PG8_BAR;
        PG8_STAGE(PG8_SB(1, 0), cB + kstep, voffB); PG8_STAGE(PG8_SA(1, 0), cA + kstep, voffA); PG8_STAGE(PG8_SB(1, 1), cB + hstepB + kstep, voffB);
        PG8_WAIT_V(6); PG8_BAR;
    }
    for (;;) {
        const bool has_next = S.next(ui + 1, nxt);
        const char* nA = has_next ? (const char*)g.A + (size_t)nxt.pm * tstepA : cA; const char* nB = has_next ? (const char*)g.Bt + (size_t)nxt.pn * tstepB : cB;
        for (int t = 0; t < nt; t += 2) {
            const bool last = (t == nt - 2);
            if constexpr (Epi::HAS_MID) { if (t == g.kmid) { const int lane_e = phase_tid(0), fr_e = lane_e & 15, fq_e = lane_e >> 4; E.mid(acc, cur, wr, wc, fr_e, fq_e); } }
            const char* a1 = cA + (size_t)(t + 1) * kstep;
            const char* a2 = last ? nA : cA + (size_t)(t + 2) * kstep; const char* b2 = last ? nB : cB + (size_t)(t + 2) * kstep;
            const char* a3 = a2 + kstep; const char* b3 = b2 + kstep;
            if (last && has_next) S.a_ready(nxt);
            if constexpr (SP2) {
            PG8_LDB(B0, 0, 0); PG8_LDB(B1, 0, 1); PG8_SCHED; PG8_LDA(At, 0, 0); PG8_STAGE(PG8_SA(1, 1), a1 + hstepA, voffA);
            PG8_WAIT_V(8); PG8_WAIT_L(0); PG8_BAR; PG8_MMA(0, 0, At, B0); PG8_MMA(0, 1, At, B1); PG8_BAR; PG8_SCHED;
            PG8_LDA(At, 0, 1); PG8_STAGE(PG8_SB(0, 0), b2, voffB); PG8_STAGE(PG8_SB(0, 1), b2 + hstepB, voffB); PG8_STAGE(PG8_SA(0, 0), a2, voffA);
            PG8_WAIT_V(8); PG8_WAIT_L(0); PG8_BAR; PG8_MMA(1, 0, At, B0); PG8_MMA(1, 1, At, B1); PG8_BAR; PG8_SCHED;
            PG8_LDB(B0, 1, 0); PG8_LDB(B1, 1, 1); PG8_SCHED; PG8_LDA(At, 1, 0); PG8_STAGE(PG8_SA(0, 1), a2 + hstepA, voffA);
            PG8_WAIT_V(8); PG8_WAIT_L(0); PG8_BAR; PG8_MMA(0, 0, At, B0); PG8_MMA(0, 1, At, B1); PG8_BAR; PG8_SCHED;
            PG8_LDA(At, 1, 1); PG8_STAGE(PG8_SB(1, 0), b3, voffB); PG8_STAGE(PG8_SB(1, 1), b3 + hstepB, voffB); PG8_STAGE(PG8_SA(1, 0), a3, voffA);
            PG8_WAIT_V(8); PG8_WAIT_L(0); PG8_BAR; PG8_MMA(1, 0, At, B0); PG8_MMA(1, 1, At, B1); PG8_BAR; PG8_SCHED;
            } else {
            PG8_LDB(B0, 0, 0); PG8_SCHED; PG8_LDA(At, 0, 0); PG8_STAGE(PG8_SA(1, 1), a1 + hstepA, voffA);
            PG8_WAIT_L(8); PG8_BAR; PG8_WAIT_L(0); PG8_MMA(0, 0, At, B0); PG8_BAR; PG8_SCHED;
            PG8_LDB(B1, 0, 1); PG8_STAGE(PG8_SB(0, 0), b2, voffB);
            PG8_BAR; PG8_WAIT_L(0); PG8_MMA(0, 1, At, B1); PG8_BAR;
            PG8_LDA(At, 0, 1); PG8_STAGE(PG8_SA(0, 0), a2, voffA);
            PG8_BAR; PG8_WAIT_L(0); PG8_MMA(1, 0, At, B0); PG8_BAR; PG8_SCHED;
            PG8_STAGE(PG8_SB(0, 1), b2 + hstepB, voffB);
            PG8_WAIT_V(6); PG8_BAR; PG8_MMA(1, 1, At, B1); PG8_BAR;
            PG8_LDB(B0, 1, 0); PG8_SCHED; PG8_LDA(At, 1, 0); PG8_STAGE(PG8_SA(0, 1), a2 + hstepA, voffA);
            PG8_WAIT_L(8); PG8_BAR; PG8_WAIT_L(0); PG8_MMA(0, 0, At, B0); PG8_BAR; PG8_SCHED;
            PG8_LDB(B1, 1, 1); PG8_STAGE(PG8_SB(1, 0), b3, voffB);
            PG8_BAR; PG8_WAIT_L(0); PG8_MMA(0, 1, At, B1); PG8_BAR;
            PG8_LDA(At, 1, 1); PG8_STAGE(PG8_SA(1, 0), a3, voffA);
            PG8_BAR; PG8_WAIT_L(0); PG8_MMA(1, 0, At, B0); PG8_BAR; PG8_SCHED;
            PG8_STAGE(PG8_SB(1, 1), b3 + hstepB, voffB);
            PG8_WAIT_V(6); PG8_BAR; PG8_MMA(1, 1, At, B1); PG8_BAR;
            }
        }
        if constexpr (ALIGN_EPI) { if (wr == 0) PG8_BAR; }
        if constexpr (!Epi::AFTER_DRAIN) { const int lane_e = phase_tid(0), fr_e = lane_e & 15, fq_e = lane_e >> 4;
            E(acc, cur, wr, wc, fr_e, fq_e); S.done(cur); }
        if (!has_next) break;
#pragma unroll
        for (int a = 0; a < 2; ++a)
#pragma unroll
            for (int b = 0; b < 2; ++b)
#pragma unroll
                for (int m = 0; m < 4; ++m)
#pragma unroll
                    for (int n = 0; n < 2; ++n) acc[a][b][m][n] = (f32x4){0.f, 0.f, 0.f, 0.f};
        cur = nxt; cA = nA; cB = nB; ++ui;
        if constexpr (ALIGN_EPI) { if (wr == 1) PG8_BAR; }
    }
    PG8_WAIT_V(0);
    if constexpr (!ALIGN_EPI) { if (wr == 0) PG8_BAR; }
    PG8_BAR;
    if constexpr (Epi::AFTER_DRAIN) { E.fused(acc, cur, wr, wc, fr, fq, lds, wid, lane); S.done(cur); }
#undef PG8_SA
#undef PG8_SB
#undef PG8_STAGE
#undef PG8_LDA
#undef PG8_LDB
#undef PG8_MMA
#undef PG8_WAIT_V
#undef PG8_WAIT_L
#undef PG8_BAR
#undef PG8_SCHED
}
}


#define LAS __attribute__((address_space(3)))
typedef unsigned short bf16_t;
typedef short bf16x8 __attribute__((ext_vector_type(8)));
typedef float f32x4 __attribute__((ext_vector_type(4)));
typedef float f32x16 __attribute__((ext_vector_type(16)));
typedef unsigned u32x4 __attribute__((ext_vector_type(4)));
typedef unsigned u32x2 __attribute__((ext_vector_type(2)));

constexpr int NB = 8, SEQ = 4096, NMETA = 16, DM = 1024, TREAL = NB * SEQ, TTOT = TREAL + NB * NMETA, MP = 33024, LPOS = SEQ + NMETA;
constexpr int NMAIN = 1792, DFF = 2816, NGU = 2 * DFF, QLORA = 384, KVLORA = 256;
constexpr float EPS = 1e-6f;
constexpr int NTHR = 512, NWAVE = 8;
constexpr int LDS_BYTES = 131072;

constexpr size_t al256(size_t x) { return (x + 255) & ~(size_t)255; }
constexpr size_t WS_ROPE = 0;
constexpr size_t ROPE_BYTES = al256(2ull * LPOS * 16 * 4);
constexpr size_t WS_SS = WS_ROPE + ROPE_BYTES;
constexpr size_t SS_FLOATS = 2ull * 4 * MP;
constexpr size_t WS_HMETA = WS_SS + al256(SS_FLOATS * 4);
constexpr size_t WS_W = WS_HMETA + 256ull * 1024 * 4;
constexpr size_t W_MAIN = 0, W_V = W_MAIN + 1792ull * 1024 * 2, W_UQ = W_V + 512ull * 1024 * 2, W_UK = W_UQ + 768ull * 384 * 2, W_UV = W_UK + 512ull * 256 * 2,
                 W_O = W_UV + 512ull * 256 * 2, W_GU = W_O + 1024ull * 1024 * 2, W_D = W_GU + 5632ull * 1024 * 2, W_LAYER = W_D + 1024ull * 2816 * 2;
constexpr size_t WS_XN = WS_W + 2 * W_LAYER;
constexpr size_t WS_G = WS_XN + (size_t)MP * 1024 * 2;
constexpr size_t G_QK = 0, G_CQ = G_QK + (size_t)MP * 1024 * 2, G_CKV = G_CQ + (size_t)MP * 384 * 2, G_KR = G_CKV + (size_t)MP * 256 * 2, G_VTS = G_KR + (size_t)MP * 32 * 2,
                 G_QM = G_VTS + 512ull * MP * 2, G_KN = G_QM + (size_t)MP * 768 * 2, G_VTM = G_KN + (size_t)MP * 512 * 2, G_O = G_VTM + 512ull * MP * 2, G_END = G_O + (size_t)MP * 1024 * 2;
constexpr size_t G_MIX = 0, G_ACT = 0, G_FFN = G_ACT + (size_t)MP * DFF * 2;
static_assert(G_MIX + (size_t)MP * 1024 * 4 <= G_QM, "mix overlays only dead buffers");
static_assert(G_FFN + (size_t)MP * 1024 * 4 <= G_END, "ffn inside group");
constexpr size_t WS_END = WS_G + G_END;

struct Params {
    const float* in[17];
    float* out; unsigned char* ws;
    float inv_freq[16];
    int ph_lo, ph_hi;
};

typedef __bf16 bf16x2_t __attribute__((ext_vector_type(2)));
typedef float f32x2_t __attribute__((ext_vector_type(2)));
__device__ __forceinline__ unsigned pk_bf16(float lo, float hi) { const f32x2_t v = {lo, hi}; const bf16x2_t b = __builtin_convertvector(v, bf16x2_t); return __builtin_bit_cast(unsigned, b); }
__device__ __forceinline__ float wave_sum(float v) {
#pragma unroll
    for (int o = 1; o < 64; o <<= 1) v += __shfl_xor(v, o);
    return v;
}
__device__ __forceinline__ int row_pos(int row) { return row < TREAL ? NMETA + (row & (SEQ - 1)) : ((row - TREAL) & (NMETA - 1)); }

namespace epi {
using pg8::Unit;
typedef const f32x4 (&AccC)[2][2][4][2];
typedef f32x4 (&AccM)[2][2][4][2];

struct Main {
    static constexpr bool PERM = false, AFTER_DRAIN = false, HAS_MID = false;
    bf16_t *qk, *cq, *ckv, *kr; float *ss_cq, *ss_ckv; const float *cosT, *sinT;
    template <int BJ, int MODE, bool SS>
    __device__ __forceinline__ void half(AccC acc, bf16_t* dst, int ldc, int c0, float* ss, int rbase, int fq) const {
#pragma unroll
        for (int ai = 0; ai < 2; ++ai)
#pragma unroll
            for (int m = 0; m < 4; ++m) {
                const int row = rbase + ai * 128 + m * 16;
                f32x4 v0 = acc[ai][BJ][m][0], v1 = acc[ai][BJ][m][1];
                if (MODE == 1) {
                    const int pos = row_pos(row);
                    const f32x4 c = *(const f32x4*)(cosT + pos * 16 + 4 * fq), s = *(const f32x4*)(sinT + pos * 16 + 4 * fq);
                    const f32x4 a = v0 * c - v1 * s, b = v1 * c + v0 * s; v0 = a; v1 = b;
                }
                bf16_t* p = dst + (size_t)row * ldc + c0;
                *(u32x2*)p = (u32x2){pk_bf16(v0[0], v0[1]), pk_bf16(v0[2], v0[3])};
                *(u32x2*)(p + 16) = (u32x2){pk_bf16(v1[0], v1[1]), pk_bf16(v1[2], v1[3])};
                if (SS) {
                    float s = (v0[0] * v0[0] + v0[1] * v0[1]) + (v0[2] * v0[2] + v0[3] * v0[3]) + (v1[0] * v1[0] + v1[1] * v1[1]) + (v1[2] * v1[2] + v1[3] * v1[3]);
                    s += __shfl_xor(s, 16); s += __shfl_xor(s, 32);
                    if (fq == 0) atomicAdd(ss + row, s);
                }
            }
    }
    __device__ __forceinline__ void operator()(AccC acc, const Unit& u, int wr, int wc, int fr, int fq) const {
        const int pn = u.pn, rbase = u.pm * 256 + wr * 64 + fr, cb = 32 * wc + 4 * fq;
        if (pn < 4) { half<0, 0, false>(acc, qk, 1024, pn * 256 + cb, nullptr, rbase, fq); half<1, 0, false>(acc, qk, 1024, pn * 256 + 128 + cb, nullptr, rbase, fq); }
        else if (pn == 4) { half<0, 0, true>(acc, cq, 384, cb, ss_cq, rbase, fq); half<1, 0, true>(acc, cq, 384, 128 + cb, ss_cq, rbase, fq); }
        else if (pn == 5) { half<0, 0, true>(acc, cq, 384, 256 + cb, ss_cq, rbase, fq); half<1, 0, true>(acc, ckv, 256, cb, ss_ckv, rbase, fq); }
        else { half<0, 0, true>(acc, ckv, 256, 128 + cb, ss_ckv, rbase, fq); if (wc == 0) half<1, 1, false>(acc, kr, 32, 4 * fq, nullptr, rbase, fq); }
    }
};
struct Bf16R {
    static constexpr bool PERM = false, AFTER_DRAIN = false, HAS_MID = false;
    bf16_t* O; int ldc; const float* ss_row; float invn_row;
    __device__ __forceinline__ void operator()(AccC acc, const Unit& u, int wr, int wc, int fr, int fq) const {
        const int rbase = u.pm * 256 + wr * 64 + fr, cbase = u.pn * 256 + 32 * wc + 4 * fq;
#pragma unroll
        for (int ai = 0; ai < 2; ++ai)
#pragma unroll
            for (int m = 0; m < 4; ++m) {
                const int row = rbase + ai * 128 + m * 16;
                const float rs = ss_row ? __builtin_amdgcn_rsqf(ss_row[row] * invn_row + EPS) : 1.f;
#pragma unroll
                for (int bj = 0; bj < 2; ++bj)
#pragma unroll
                    for (int n = 0; n < 2; ++n) {
                        const f32x4 v = acc[ai][bj][m][n] * rs;
                        *(u32x2*)(O + (size_t)row * ldc + cbase + bj * 128 + n * 16) = (u32x2){pk_bf16(v[0], v[1]), pk_bf16(v[2], v[3])};
                    }
                asm volatile("" ::: "memory");
            }
    }
};
struct Bf16C {
    static constexpr bool PERM = false, AFTER_DRAIN = false, HAS_MID = false;
    bf16_t* O; int ldc; const float* ss_col; float invn_col;
    __device__ __forceinline__ void operator()(AccC acc, const Unit& u, int wr, int wc, int fr, int fq) const {
        const int rbase = u.pm * 256 + wr * 64 + fr, cbase = u.pn * 256 + 32 * wc + 4 * fq;
#pragma unroll
        for (int bj = 0; bj < 2; ++bj)
#pragma unroll
            for (int n = 0; n < 2; ++n) {
                const f32x4 q = *(const f32x4*)(ss_col + cbase + bj * 128 + n * 16); f32x4 cs;
#pragma unroll
                for (int i = 0; i < 4; ++i) cs[i] = __builtin_amdgcn_rsqf(q[i] * invn_col + EPS);
#pragma unroll
                for (int ai = 0; ai < 2; ++ai)
#pragma unroll
                    for (int m = 0; m < 4; ++m) {
                        const int row = rbase + ai * 128 + m * 16;
                        const f32x4 v = acc[ai][bj][m][n] * cs;
                        *(u32x2*)(O + (size_t)row * ldc + cbase + bj * 128 + n * 16) = (u32x2){pk_bf16(v[0], v[1]), pk_bf16(v[2], v[3])};
                    }
                asm volatile("" ::: "memory");
            }
    }
};
struct QMla {
    static constexpr bool PERM = false, AFTER_DRAIN = false, HAS_MID = false;
    bf16_t* O; const float* ss; const float *cosT, *sinT;
    __device__ __forceinline__ void operator()(AccC acc, const Unit& u, int wr, int wc, int fr, int fq) const {
        const int rbase = u.pm * 256 + wr * 64 + fr;
#pragma unroll
        for (int ai = 0; ai < 2; ++ai)
#pragma unroll
            for (int m = 0; m < 4; ++m) {
                const int row = rbase + ai * 128 + m * 16;
                const float rs = __builtin_amdgcn_rsqf(ss[row] * (1.f / QLORA) + EPS);
                const int pos = row_pos(row);
#pragma unroll
                for (int bj = 0; bj < 2; ++bj) {
                    const int colg = u.pn * 256 + bj * 128 + 32 * wc;
                    f32x4 v0 = acc[ai][bj][m][0] * rs, v1 = acc[ai][bj][m][1] * rs;
                    if (((colg >> 5) % 3) == 2) {
                        const f32x4 c = *(const f32x4*)(cosT + pos * 16 + 4 * fq), s = *(const f32x4*)(sinT + pos * 16 + 4 * fq);
                        const f32x4 a = v0 * c - v1 * s, b = v1 * c + v0 * s; v0 = a; v1 = b;
                    }
                    bf16_t* p = O + (size_t)row * 768 + colg + 4 * fq;
                    *(u32x2*)p = (u32x2){pk_bf16(v0[0], v0[1]), pk_bf16(v0[2], v0[3])};
                    *(u32x2*)(p + 16) = (u32x2){pk_bf16(v1[0], v1[1]), pk_bf16(v1[2], v1[3])};
                }
                asm volatile("" ::: "memory");
            }
    }
};
struct Wo {
    static constexpr bool PERM = false, AFTER_DRAIN = false, HAS_MID = true;
    float* O; const float *ss_sb, *ss_mla;
    __device__ __forceinline__ void mid(AccM acc, const Unit& u, int wr, int wc, int fr, int fq) const {
        int rbase = u.pm * 256 + wr * 64 + fr; asm volatile("" : "+v"(rbase) :: "memory");
#pragma unroll
        for (int ai = 0; ai < 2; ++ai)
#pragma unroll
            for (int m = 0; m < 4; ++m) {
                const int row = rbase + ai * 128 + m * 16;
                const float r = __builtin_amdgcn_rsqf(ss_sb[row] * (1.f / 512) + EPS) * __builtin_amdgcn_sqrtf(ss_mla[row] * (1.f / 512) + EPS);
#pragma unroll
                for (int bj = 0; bj < 2; ++bj)
#pragma unroll
                    for (int n = 0; n < 2; ++n) acc[ai][bj][m][n] *= r;
            }
    }
    __device__ __forceinline__ void operator()(AccC acc, const Unit& u, int wr, int wc, int fr, int fq) const {
        const int rbase = u.pm * 256 + wr * 64 + fr, cbase = u.pn * 256 + 32 * wc + 4 * fq;
#pragma unroll
        for (int ai = 0; ai < 2; ++ai)
#pragma unroll
            for (int m = 0; m < 4; ++m) {
                const int row = rbase + ai * 128 + m * 16;
                const float r = __builtin_amdgcn_rsqf(ss_mla[row] * (1.f / 512) + EPS);
#pragma unroll
                for (int bj = 0; bj < 2; ++bj)
#pragma unroll
                    for (int n = 0; n < 2; ++n) *(f32x4*)(O + (size_t)row * 1024 + cbase + bj * 128 + n * 16) = acc[ai][bj][m][n] * r;
            }
    }
};
struct GateUp {
    static constexpr bool PERM = false, AFTER_DRAIN = false, HAS_MID = false;
    bf16_t* O;
    __device__ __forceinline__ void operator()(AccC acc, const Unit& u, int wr, int wc, int fr, int fq) const {
        const int rbase = u.pm * 256 + wr * 64 + fr, cbase = u.pn * 128 + 16 * wc + 4 * fq;
#pragma unroll
        for (int ai = 0; ai < 2; ++ai)
#pragma unroll
            for (int m = 0; m < 4; ++m) {
                const int row = rbase + ai * 128 + m * 16;
#pragma unroll
                for (int bj = 0; bj < 2; ++bj) {
                    const f32x4 g = acc[ai][bj][m][0], up = acc[ai][bj][m][1]; f32x4 a;
#pragma unroll
                    for (int i = 0; i < 4; ++i) a[i] = g[i] * __builtin_amdgcn_rcpf(1.f + __builtin_amdgcn_exp2f(-1.44269504089f * g[i])) * up[i];
                    *(u32x2*)(O + (size_t)row * DFF + cbase + bj * 64) = (u32x2){pk_bf16(a[0], a[1]), pk_bf16(a[2], a[3])};
                }
            }
    }
};
struct F32Out {
    static constexpr bool PERM = false, AFTER_DRAIN = false, HAS_MID = false;
    float* O;
    __device__ __forceinline__ void operator()(AccC acc, const Unit& u, int wr, int wc, int fr, int fq) const {
        const int rbase = u.pm * 256 + wr * 64 + fr, cbase = u.pn * 256 + 32 * wc + 4 * fq;
#pragma unroll
        for (int ai = 0; ai < 2; ++ai)
#pragma unroll
            for (int m = 0; m < 4; ++m) {
                const int row = rbase + ai * 128 + m * 16;
#pragma unroll
                for (int bj = 0; bj < 2; ++bj)
#pragma unroll
                    for (int n = 0; n < 2; ++n) *(f32x4*)(O + (size_t)row * 1024 + cbase + bj * 128 + n * 16) = acc[ai][bj][m][n];
            }
    }
};
}

template <class Epi>
__device__ __forceinline__ void run_gemm(LAS unsigned char* lds, const bf16_t* A, int lda, const bf16_t* Bt, int ldb, int M, int N, int K, int kmid, int rot, const Epi& E, int wave_s) {
    pg8::Gemm g{A, Bt, M, N, K, lda, ldb, kmid};
    int bx = (int)blockIdx.x, G = (int)gridDim.x; asm volatile("" : "+s"(bx), "+s"(G));
    pg8::StaticOrder S; S.init(M, N, G, (bx + G - (rot % G)) % G);
    pg8::gemm_phase<Epi, pg8::StaticOrder, true, true>(lds, g, S, E, wave_s);
}

__device__ __forceinline__ void tr_item(const float* W, int ldw, int scol0, int k0, const float* kg0, const float* kg1, float scale, bf16_t* WT, int K, int drow0, int mode, LAS float* scr, int lane) {
#pragma unroll 8
    for (int i = 0; i < 32; ++i) {
        const int kk = 2 * i + (lane >> 5), k = k0 + kk; float g = scale;
        if (kg0) g *= (kg1 && k >= 512) ? kg1[k - 512] : kg0[k];
        scr[kk * 33 + (lane & 31)] = W[(size_t)k * ldw + scol0 + (lane & 31)] * g;
    }
    asm volatile("s_waitcnt lgkmcnt(0)" ::: "memory");
    const int c = lane & 7;
#pragma unroll
    for (int j = 0; j < 4; ++j) {
        const int n = (lane >> 3) + 8 * j; const LAS float* s = scr + (8 * c) * 33 + n;
        u32x4 o; o.x = pk_bf16(s[0 * 33], s[1 * 33]); o.y = pk_bf16(s[2 * 33], s[3 * 33]); o.z = pk_bf16(s[4 * 33], s[5 * 33]); o.w = pk_bf16(s[6 * 33], s[7 * 33]);
        const int drow = drow0 + (mode ? 32 * (n >> 4) + (n & 15) : n);
        *(u32x4*)(WT + (size_t)drow * K + k0 + 8 * c) = o;
    }
    asm volatile("s_waitcnt lgkmcnt(0)" ::: "memory");
}

constexpr float SCALE_QMLA = 0.10206207261596575f * 1.4426950408889634f;
constexpr int ITEMS_PER_LAYER = 6112;

__device__ __forceinline__ void convert_item(const Params& p, int layer, int it, LAS float* scr, int lane) {
    unsigned char* wl = p.ws + WS_W + (size_t)layer * W_LAYER;
    const float* w_in = p.in[2] + (size_t)layer * 1024 * 2208;
    constexpr int IT_SEG[12] = {0, 256, 512, 768, 1104, 1248, 1312, 1376, 1888, 3296, 4704, 6112};
    int seg = 0;
#pragma unroll
    for (int s = 1; s < 11; ++s) if (it >= IT_SEG[s]) seg = s;
    const int r = it - IT_SEG[seg];
    switch (seg) {
    case 0: { const int nb = r % 16, kb = r / 16; tr_item(w_in, 2208, 32 * nb, 64 * kb, nullptr, nullptr, 0.125f, (bf16_t*)(wl + W_MAIN), 1024, 32 * nb, 0, scr, lane); break; }
    case 1: { const int nb = r % 16, kb = r / 16; tr_item(w_in, 2208, 512 + 32 * nb, 64 * kb, nullptr, nullptr, 1.f, (bf16_t*)(wl + W_MAIN), 1024, 512 + 32 * nb, 0, scr, lane); break; }
    case 2: { const int nb = r % 16, kb = r / 16; tr_item(w_in, 2208, 1024 + 32 * nb, 64 * kb, nullptr, nullptr, 1.f, (bf16_t*)(wl + W_V), 1024, 32 * nb, 0, scr, lane); break; }
    case 3: { const int nb = r % 21, kb = r / 21; tr_item(w_in, 2208, 1536 + 32 * nb, 64 * kb, nullptr, nullptr, 1.f, (bf16_t*)(wl + W_MAIN), 1024, 1024 + 32 * nb, 0, scr, lane); break; }
    case 4: { const int nb = r % 24, kb = r / 24; tr_item(p.in[5] + (size_t)layer * 384 * 768, 768, 32 * nb, 64 * kb, p.in[3] + layer * 384, nullptr, SCALE_QMLA, (bf16_t*)(wl + W_UQ), 384, 32 * nb, 0, scr, lane); break; }
    case 5: { const int nb = r % 16, kb = r / 16; const int n0 = 32 * nb; tr_item(p.in[6] + (size_t)layer * 256 * 1024, 1024, 128 * (n0 >> 6) + (n0 & 63), 64 * kb, p.in[4] + layer * 256, nullptr, 1.f, (bf16_t*)(wl + W_UK), 256, n0, 0, scr, lane); break; }
    case 6: { const int nb = r % 16, kb = r / 16; const int n0 = 32 * nb; tr_item(p.in[6] + (size_t)layer * 256 * 1024, 1024, 128 * (n0 >> 6) + 64 + (n0 & 63), 64 * kb, p.in[4] + layer * 256, nullptr, 1.f, (bf16_t*)(wl + W_UV), 256, n0, 0, scr, lane); break; }
    case 7: { const int nb = r % 32, kb = r / 32; tr_item(p.in[9] + (size_t)layer * 1024 * 1024, 1024, 32 * nb, 64 * kb, p.in[7] + layer * 512, p.in[8] + layer * 512, 1.f, (bf16_t*)(wl + W_O), 1024, 32 * nb, 0, scr, lane); break; }
    case 8: { const int nb = r % 88, kb = r / 88; tr_item(p.in[14] + (size_t)layer * 1024 * DFF, DFF, 32 * nb, 64 * kb, nullptr, nullptr, 1.f, (bf16_t*)(wl + W_GU), 1024, 64 * nb, 1, scr, lane); break; }
    case 9: { const int nb = r % 88, kb = r / 88; tr_item(p.in[15] + (size_t)layer * 1024 * DFF, DFF, 32 * nb, 64 * kb, nullptr, nullptr, 1.f, (bf16_t*)(wl + W_GU), 1024, 64 * nb + 16, 1, scr, lane); break; }
    default: { const int nb = r % 32, kb = r / 32; tr_item(p.in[16] + (size_t)layer * DFF * 1024, 1024, 32 * nb, 64 * kb, nullptr, nullptr, 1.f, (bf16_t*)(wl + W_D), DFF, 32 * nb, 0, scr, lane); break; }
    }
}

__device__ __forceinline__ void sincos_f64(double a, double& s, double& c) {
    const double k = rint(a * 0.63661977236758134308);
    double r = fma(-k, 1.57079632679489655800e+00, a); r = fma(-k, 6.12323399573676603587e-17, r);
    const double r2 = r * r;
    double sp = -1.0 / 1307674368000.0; sp = fma(sp, r2, 1.0 / 6227020800.0); sp = fma(sp, r2, -1.0 / 39916800.0); sp = fma(sp, r2, 1.0 / 362880.0); sp = fma(sp, r2, -1.0 / 5040.0); sp = fma(sp, r2, 1.0 / 120.0); sp = fma(sp, r2, -1.0 / 6.0);
    const double sr = fma(sp * r2, r, r);
    double cp = 1.0 / 20922789888000.0; cp = fma(cp, r2, -1.0 / 87178291200.0); cp = fma(cp, r2, 1.0 / 479001600.0); cp = fma(cp, r2, -1.0 / 3628800.0); cp = fma(cp, r2, 1.0 / 40320.0); cp = fma(cp, r2, -1.0 / 720.0); cp = fma(cp, r2, 1.0 / 24.0); cp = fma(cp, r2, -0.5);
    const double cr = fma(cp, r2, 1.0);
    const int q = ((int)k) & 3;
    s = (q == 0) ? sr : (q == 1) ? cr : (q == 2) ? -sr : -cr;
    c = (q == 0) ? cr : (q == 1) ? -sr : (q == 2) ? -cr : sr;
}

__device__ __forceinline__ void row_step(const float* y, const float* gy, float* hrow, const float* hsrc, const float* gx, bf16_t* xn, int lane) {
    f32x4 v[4];
#pragma unroll
    for (int j = 0; j < 4; ++j) v[j] = *((const f32x4*)hsrc + lane + 64 * j);
    if (y) {
        f32x4 t[4]; float s = 0.f;
#pragma unroll
        for (int j = 0; j < 4; ++j) { t[j] = *((const f32x4*)y + lane + 64 * j); s += (t[j][0] * t[j][0] + t[j][1] * t[j][1]) + (t[j][2] * t[j][2] + t[j][3] * t[j][3]); }
        const float rs = 1.0f / sqrtf(wave_sum(s) * (1.f / DM) + EPS);
#pragma unroll
        for (int j = 0; j < 4; ++j) { const f32x4 g = *((const f32x4*)gy + lane + 64 * j); v[j] += t[j] * rs * g; }
    }
#pragma unroll
    for (int j = 0; j < 4; ++j) *((f32x4*)hrow + lane + 64 * j) = v[j];
    if (xn) {
        float s = 0.f;
#pragma unroll
        for (int j = 0; j < 4; ++j) s += (v[j][0] * v[j][0] + v[j][1] * v[j][1]) + (v[j][2] * v[j][2] + v[j][3] * v[j][3]);
        const float rs = 1.0f / sqrtf(wave_sum(s) * (1.f / DM) + EPS);
#pragma unroll
        for (int j = 0; j < 4; ++j) { const f32x4 g = *((const f32x4*)gx + lane + 64 * j); const f32x4 o = v[j] * rs * g;
            *((u32x2*)xn + lane + 64 * j) = (u32x2){pk_bf16(o[0], o[1]), pk_bf16(o[2], o[3])}; }
    }
}
__device__ __forceinline__ float* h_row(const Params& p, int row) { return row < TREAL ? p.out + (size_t)row * DM : (float*)(p.ws + WS_HMETA) + (size_t)(row - TREAL) * DM; }

__device__ __forceinline__ void phase_prologue(const Params& p, LAS unsigned char* lds, int wave_s) {
    int tid_ = phase_tid(wave_s);
    const int tid = tid_, lane = tid & 63, wave = tid >> 6, G = gridDim.x;
    const int gt = blockIdx.x * NTHR + tid, NGT = G * NTHR, gw = blockIdx.x * NWAVE + wave, NGW = G * NWAVE;
    float* ss = (float*)(p.ws + WS_SS);
    for (size_t i = gt; i < SS_FLOATS; i += NGT) ss[i] = 0.f;
    float* cosT = (float*)(p.ws + WS_ROPE); float* sinT = cosT + LPOS * 16;
    for (int i = gt; i < LPOS * 16; i += NGT) { const int pos = i >> 4, j = i & 15; const float ang = (float)pos * p.inv_freq[j]; double s, c; sincos_f64((double)ang, s, c); cosT[i] = (float)c; sinT[i] = (float)s; }
    for (int l = 0; l < 2; ++l) {
        u32x4* z = (u32x4*)(p.ws + WS_W + (size_t)l * W_LAYER + W_MAIN + 1696ull * 1024 * 2);
        for (int i = gt; i < 96 * 1024 * 2 / 16; i += NGT) z[i] = (u32x4){0u, 0u, 0u, 0u};
    }
    LAS float* scr = (LAS float*)(lds + wave * 16384);
    for (int it = gw; it < 2 * ITEMS_PER_LAYER; it += NGW) { const int layer = it >= ITEMS_PER_LAYER ? 1 : 0; convert_item(p, layer, it - layer * ITEMS_PER_LAYER, scr, lane); }
    bf16_t* xn = (bf16_t*)(p.ws + WS_XN);
    for (int row = gw; row < TTOT; row += NGW) {
        const float* src = row < TREAL ? p.in[0] + (size_t)row * DM : p.in[1] + (size_t)((row - TREAL) & 15) * DM;
        row_step(nullptr, nullptr, h_row(p, row), src, p.in[10], xn + (size_t)row * DM, lane);
    }
}
__device__ __forceinline__ void phase_rows(const Params& p, const float* y, const float* gy, const float* gx, bool make_xn, int wave_s) {
    int tid_ = phase_tid(wave_s);
    const int tid = tid_, lane = tid & 63, wave = tid >> 6, gw = blockIdx.x * NWAVE + wave, NGW = gridDim.x * NWAVE;
    bf16_t* xn = (bf16_t*)(p.ws + WS_XN);
    for (int row = gw; row < TTOT; row += NGW) { float* h = h_row(p, row); row_step(y + (size_t)row * DM, gy, h, h, gx, make_xn ? xn + (size_t)row * DM : nullptr, lane); }
}

namespace att {
constexpr int KS_SB = 144, KS_ML = 208, VS = 144;
constexpr int KB0 = 0, KBSZ = 64 * KS_ML, VB0 = 2 * KBSZ, VBSZ = 64 * VS, FLG = VB0 + 2 * VBSZ;
__device__ __forceinline__ int pi_row(int m) { return 16 * (m >> 4) + 8 * ((m >> 2) & 1) + 4 * ((m >> 3) & 1) + (m & 3); }
#define MFMA32(a, b, c) __builtin_amdgcn_mfma_f32_32x32x16_bf16(a, b, c, 0, 0, 0)
__device__ __forceinline__ bf16x8 pack8(const f32x16& s, int o) {
    u32x4 w; w.x = pk_bf16(s[o + 0], s[o + 1]); w.y = pk_bf16(s[o + 2], s[o + 3]); w.z = pk_bf16(s[o + 4], s[o + 5]); w.w = pk_bf16(s[o + 6], s[o + 7]);
    return __builtin_bit_cast(bf16x8, w);
}
__device__ __forceinline__ void store_o(const f32x16& o0, const f32x16& o1, float inv, bf16_t* orow, float* ssrow, int hi, bool valid) {
    float ssq = 0.f;
#pragma unroll
    for (int db = 0; db < 2; ++db)
#pragma unroll
        for (int a = 0; a < 4; ++a) {
            const f32x16& o = db ? o1 : o0;
            const float v0 = o[4 * a] * inv, v1 = o[4 * a + 1] * inv, v2 = o[4 * a + 2] * inv, v3 = o[4 * a + 3] * inv;
            ssq += (v0 * v0 + v1 * v1) + (v2 * v2 + v3 * v3);
            if (valid) *(u32x2*)(orow + 32 * db + 8 * a + 4 * hi) = (u32x2){pk_bf16(v0, v1), pk_bf16(v2, v3)};
        }
    ssq += __shfl_xor(ssq, 32);
    if (valid && hi == 0) atomicAdd(ssrow, ssq);
}

__device__ __forceinline__ void mla_unit(int wave_s, LAS unsigned char* lds, const bf16_t* Q, const bf16_t* Kn, const bf16_t* Kr, const bf16_t* VT, bf16_t* O, float* ss, int b, int h, int qb) {
    int tid_ = phase_tid(wave_s);
    const int tid = tid_, lane = tid & 63, w = __builtin_amdgcn_readfirstlane(tid >> 6), ql = lane & 31, hi = lane >> 5;
    const bool meta = qb < 0;
    const int qrow = meta ? (TREAL + b * 16 + (ql & 15)) : (b * SEQ + qb * 256 + w * 32 + ql);
    const int qt = meta ? ql : (qb * 256 + w * 32 + ql);
    bf16x8 qf[6];
#pragma unroll
    for (int ks = 0; ks < 6; ++ks) qf[ks] = *(const bf16x8*)(Q + (size_t)qrow * 768 + h * 96 + (2 * ks + hi) * 8);
    const int ntiles = meta ? 1 : 4 * qb + 5;
    const int wlast = meta ? (w == 0 ? 0 : -1) : 1 + 4 * qb + (w >> 1);
    const int krow = tid >> 3, kch = tid & 7, rrow = tid >> 2, rch = tid & 3;
    const unsigned aoff = (unsigned)(pi_row(ql) * KS_ML + hi * 16), voff = (unsigned)(ql * VS + hi * 16);
    float mrun = -INFINITY, lrun = 0.f;
    f32x16 o0, o1;
#pragma unroll
    for (int i = 0; i < 16; ++i) { o0[i] = 0.f; o1[i] = 0.f; }
    u32x4 rk, rr = (u32x4){0u, 0u, 0u, 0u}, rv;
    auto gload = [&](int i) {
        const int row0 = (i == 0) ? TREAL + b * 16 : b * SEQ + 64 * (i - 1);
        rk = *(const u32x4*)(Kn + (size_t)(row0 + krow) * 512 + h * 64 + kch * 8);
        if (tid < 256) rr = *(const u32x4*)(Kr + (size_t)(row0 + rrow) * 32 + rch * 8);
        rv = *(const u32x4*)(VT + (size_t)(h * 64 + krow) * MP + row0 + kch * 8);
    };
    auto lstore = [&](int buf) {
        *(LAS u32x4*)(lds + KB0 + buf * KBSZ + krow * KS_ML + kch * 16) = rk;
        if (tid < 256) *(LAS u32x4*)(lds + KB0 + buf * KBSZ + rrow * KS_ML + 128 + rch * 16) = rr;
        *(LAS u32x4*)(lds + VB0 + buf * VBSZ + krow * VS + kch * 16) = rv;
    };
    gload(0); lstore(0); __syncthreads();
    for (int i = 0; i < ntiles; ++i) {
        const int buf = i & 1;
        if (i + 1 < ntiles) gload(i + 1);
        if (i <= wlast) {
            const LAS unsigned char* kb = lds + KB0 + buf * KBSZ + aoff; const LAS unsigned char* vb = lds + VB0 + buf * VBSZ + voff;
            f32x16 s0, s1;
#pragma unroll
            for (int r = 0; r < 16; ++r) { s0[r] = 0.f; s1[r] = 0.f; }
#pragma unroll
            for (int ks = 0; ks < 6; ++ks) {
                const bf16x8 a0 = *(const LAS bf16x8*)(kb + ks * 32), a1 = *(const LAS bf16x8*)(kb + 32 * KS_ML + ks * 32);
                s0 = MFMA32(a0, qf[ks], s0); s1 = MFMA32(a1, qf[ks], s1);
            }
            const int lim = (i == 0) ? (meta ? (ql < 15 ? ql : 15) : 15) : qt - 64 * (i - 1);
            if (__ballot(lim < 63) != 0ull) {
#pragma unroll
                for (int r = 0; r < 16; ++r) { const int ki = 16 * (r >> 3) + 8 * hi + (r & 7); if (ki > lim) s0[r] = -INFINITY; if (ki + 32 > lim) s1[r] = -INFINITY; }
            }
            float mx = fmaxf(s0[0], s1[0]);
#pragma unroll
            for (int r = 1; r < 16; ++r) mx = fmaxf(mx, fmaxf(s0[r], s1[r]));
            mx = fmaxf(mx, __shfl_xor(mx, 32));
            const float mn = fmaxf(mrun, mx), alpha = __builtin_amdgcn_exp2f(mrun - mn); mrun = mn;
            float rs = 0.f;
#pragma unroll
            for (int r = 0; r < 16; ++r) { s0[r] = __builtin_amdgcn_exp2f(s0[r] - mn); s1[r] = __builtin_amdgcn_exp2f(s1[r] - mn); rs += s0[r] + s1[r]; }
            lrun = lrun * alpha + rs;
#pragma unroll
            for (int r = 0; r < 16; ++r) { o0[r] *= alpha; o1[r] *= alpha; }
#pragma unroll
            for (int s = 0; s < 4; ++s) {
                const bf16x8 pf = pack8((s >> 1) ? s1 : s0, 8 * (s & 1));
                const bf16x8 v0 = *(const LAS bf16x8*)(vb + s * 32), v1 = *(const LAS bf16x8*)(vb + 32 * VS + s * 32);
                o0 = MFMA32(v0, pf, o0); o1 = MFMA32(v1, pf, o1);
            }
        }
        if (i + 1 < ntiles) lstore(buf ^ 1);
        __syncthreads();
    }
    lrun += __shfl_xor(lrun, 32);
    const bool valid = meta ? (w == 0 && ql < 16) : true;
    store_o(o0, o1, 1.0f / lrun, O + (size_t)qrow * 1024 + 512 + h * 64, ss + qrow, hi, valid);
}

__device__ __forceinline__ void sb_unit(int wave_s, LAS unsigned char* lds, const bf16_t* QK, const bf16_t* VT, bf16_t* O, float* ss, int b, int h, int qb) {
    int tid_ = phase_tid(wave_s);
    const int tid = tid_, lane = tid & 63, w = __builtin_amdgcn_readfirstlane(tid >> 6), ql = lane & 31, hi = lane >> 5;
    const bool meta = qb < 0;
    const int qrow = meta ? (TREAL + b * 16 + (ql & 15)) : (b * SEQ + qb * 256 + w * 32 + ql);
    const int qt = meta ? ql : (qb * 256 + w * 32 + ql);
    bf16x8 qf[4];
#pragma unroll
    for (int ks = 0; ks < 4; ++ks) qf[ks] = *(const bf16x8*)(QK + (size_t)qrow * 1024 + h * 64 + (2 * ks + hi) * 8);
    const int ntiles = meta ? 1 : 4 * qb + 5;
    const int wfirst = meta ? (w == 0 ? 0 : 1) : 3 - (w >> 1);
    const int krow = tid >> 3, kch = tid & 7;
    const unsigned aoff = (unsigned)(pi_row(ql) * KS_SB + hi * 16), voff = (unsigned)(ql * VS + hi * 16);
    f32x16 o0, o1;
#pragma unroll
    for (int i = 0; i < 16; ++i) { o0[i] = 0.f; o1[i] = 0.f; }
    float carry = 0.f;
    u32x4 rk, rv;
    auto gload = [&](int i) {
        const int row0 = (meta || i == ntiles - 1) ? TREAL + b * 16 : b * SEQ + 64 * (4 * qb + 3 - i);
        rk = *(const u32x4*)(QK + (size_t)(row0 + krow) * 1024 + 512 + h * 64 + kch * 8);
        rv = *(const u32x4*)(VT + (size_t)(h * 64 + krow) * MP + row0 + kch * 8);
    };
    auto lstore = [&](int buf) {
        *(LAS u32x4*)(lds + KB0 + buf * KBSZ + krow * KS_SB + kch * 16) = rk;
        *(LAS u32x4*)(lds + VB0 + buf * VBSZ + krow * VS + kch * 16) = rv;
    };
    LAS int* flg = (LAS int*)(lds + FLG);
    gload(0); lstore(0); __syncthreads();
    for (int i = 0; i < ntiles; ++i) {
        const int buf = i & 1;
        if (i > 0) {
            int all = 1;
#pragma unroll
            for (int k = 0; k < NWAVE; ++k) all &= flg[(buf ^ 1) * NWAVE + k];
#ifndef NO_EXIT
            if (all) break;
#endif
        }
        if (i + 1 < ntiles) gload(i + 1);
        if (i >= wfirst) {
            const LAS unsigned char* kb = lds + KB0 + buf * KBSZ + aoff; const LAS unsigned char* vb = lds + VB0 + buf * VBSZ + voff;
            f32x16 s0, s1, l0, l1;
#pragma unroll
            for (int r = 0; r < 16; ++r) { s0[r] = 0.f; s1[r] = 0.f; }
#pragma unroll
            for (int ks = 0; ks < 4; ++ks) {
                const bf16x8 a0 = *(const LAS bf16x8*)(kb + ks * 32), a1 = *(const LAS bf16x8*)(kb + 32 * KS_SB + ks * 32);
                s0 = MFMA32(a0, qf[ks], s0); s1 = MFMA32(a1, qf[ks], s1);
            }
            const bool mtile = meta || i == ntiles - 1;
            const int lim = mtile ? (meta ? (ql < 16 ? ql - 1 : 15) : 15) : qt - 64 * (4 * qb + 3 - i) - 1;
#pragma unroll
            for (int r = 0; r < 16; ++r) {
                const int ki = 16 * (r >> 3) + 8 * hi + (r & 7);
                { const float z = s0[r], sp = fmaxf(z, 0.f) + 0.69314718056f * __builtin_amdgcn_logf(1.f + __builtin_amdgcn_exp2f(-1.44269504089f * fabsf(z))); const bool ok = ki <= lim; l0[r] = ok ? -sp : 0.f; s0[r] = ok ? z : -INFINITY; }
                { const float z = s1[r], sp = fmaxf(z, 0.f) + 0.69314718056f * __builtin_amdgcn_logf(1.f + __builtin_amdgcn_exp2f(-1.44269504089f * fabsf(z))); const bool ok = ki + 32 <= lim; l1[r] = ok ? -sp : 0.f; s1[r] = ok ? z : -INFINITY; }
            }
            float og[4], pg[4];
#pragma unroll
            for (int q = 0; q < 4; ++q) { const f32x16& l = (q >> 1) ? l1 : l0; const int o = 8 * (q & 1);
                og[q] = ((l[o] + l[o + 1]) + (l[o + 2] + l[o + 3])) + ((l[o + 4] + l[o + 5]) + (l[o + 6] + l[o + 7])); pg[q] = __shfl_xor(og[q], 32); }
            float tail = carry;
#pragma unroll
            for (int q = 3; q >= 0; --q) {
                f32x16& l = (q >> 1) ? l1 : l0; f32x16& s = (q >> 1) ? s1 : s0; const int o = 8 * (q & 1);
                float run = tail + (hi == 0 ? pg[q] : 0.f);
#pragma unroll
                for (int j = 7; j >= 0; --j) { const float lm = l[o + j]; s[o + j] = __builtin_amdgcn_exp2f(1.44269504089f * (s[o + j] + lm + run)); run += lm; }
                tail += og[q] + pg[q];
            }
            carry = tail;
#pragma unroll
            for (int s = 0; s < 4; ++s) {
                const bf16x8 pf = pack8((s >> 1) ? s1 : s0, 8 * (s & 1));
                const bf16x8 v0 = *(const LAS bf16x8*)(vb + s * 32), v1 = *(const LAS bf16x8*)(vb + 32 * VS + s * 32);
                o0 = MFMA32(v0, pf, o0); o1 = MFMA32(v1, pf, o1);
            }
        }
        { const int dn = (__ballot(carry >= -104.0f) == 0ull) ? 1 : 0; if (lane == 0) flg[buf * NWAVE + w] = dn; }
        if (i + 1 < ntiles) lstore(buf ^ 1);
        __syncthreads();
    }
    __syncthreads();
    const bool valid = meta ? (w == 0 && ql < 16) : true;
    store_o(o0, o1, 1.0f, O + (size_t)qrow * 1024 + h * 64, ss + qrow, hi, valid);
}

__device__ __forceinline__ void phase_attention(const Params& p, LAS unsigned char* lds, int layer, int wave_s) {
    unsigned char* g = p.ws + WS_G;
    const bf16_t* QK = (const bf16_t*)(g + G_QK); const bf16_t* VTS = (const bf16_t*)(g + G_VTS);
    const bf16_t* QM = (const bf16_t*)(g + G_QM); const bf16_t* KN = (const bf16_t*)(g + G_KN); const bf16_t* KR = (const bf16_t*)(g + G_KR); const bf16_t* VTM = (const bf16_t*)(g + G_VTM);
    bf16_t* O = (bf16_t*)(g + G_O);
    float* ss_sb = (float*)(p.ws + WS_SS) + (size_t)(layer * 4 + 2) * MP; float* ss_ml = ss_sb + MP;
    for (int idx = blockIdx.x; idx < 2176; idx += gridDim.x) {
        if (idx < 1024) {
            const int rnd = idx >> 8, cc = idx & 255, grp = cc >> 6, bh = cc & 63;
            const int qb = rnd == 0 ? 15 - grp : rnd == 1 ? 8 + grp : rnd == 2 ? 7 - grp : grp;
            mla_unit(wave_s, lds, QM, KN, KR, VTM, O, ss_ml, bh >> 3, bh & 7, qb);
        } else if (idx < 2048) {
            const int k = idx - 1024, bh = k & 63, qb = k >> 6;
            sb_unit(wave_s, lds, QK, VTS, O, ss_sb, bh >> 3, bh & 7, qb);
        } else if (idx < 2112) { const int bh = idx - 2048; mla_unit(wave_s, lds, QM, KN, KR, VTM, O, ss_ml, bh >> 3, bh & 7, -1); }
        else { const int bh = idx - 2112; sb_unit(wave_s, lds, QK, VTS, O, ss_sb, bh >> 3, bh & 7, -1); }
    }
}
}

__global__ void __launch_bounds__(NTHR) hybrid_fwd(Params p) {
    extern __shared__ __attribute__((aligned(16))) unsigned char smem[];
    LAS unsigned char* lds = (LAS unsigned char*)smem;
    cg::grid_group grid = cg::this_grid();
    const int wave_s = __builtin_amdgcn_readfirstlane((int)threadIdx.x >> 6);
    unsigned char* ws = p.ws; unsigned char* g = ws + WS_G;
    const float* cosT = (const float*)(ws + WS_ROPE); const float* sinT = cosT + LPOS * 16;
    bf16_t* xn = (bf16_t*)(ws + WS_XN);
    const int lo = p.ph_lo, hi = p.ph_hi;
    int ph = 0;
#ifndef PHMASK
#define PHMASK 0xFFFFFFFFu
#endif
#define PHASE_BEGIN if (ph >= lo && ph < hi) {
#define PHASE_END   if (ph + 1 < hi) grid.sync(); } ++ph;

    PHASE_BEGIN if (PHMASK & 1u) phase_prologue(p, lds, wave_s); PHASE_END
    for (int layer = 0; layer < 2; ++layer) {
        unsigned char* wl = ws + WS_W + (size_t)layer * W_LAYER;
        float* ssb = (float*)(ws + WS_SS) + (size_t)layer * 4 * MP;
        float *ss_cq = ssb, *ss_ckv = ssb + MP, *ss_osb = ssb + 2 * MP, *ss_oml = ssb + 3 * MP;
        PHASE_BEGIN if (PHMASK & 2u) {
            epi::Main E{(bf16_t*)(g + G_QK), (bf16_t*)(g + G_CQ), (bf16_t*)(g + G_CKV), (bf16_t*)(g + G_KR), ss_cq, ss_ckv, cosT, sinT};
#ifndef NO_A
            run_gemm(lds, xn, 1024, (const bf16_t*)(wl + W_MAIN), 1024, MP, NMAIN, 1024, -1, 0, E, wave_s);
#endif
            epi::Bf16R EV{(bf16_t*)(g + G_VTS), MP, nullptr, 0.f};
#ifndef NO_B
            run_gemm(lds, (const bf16_t*)(wl + W_V), 1024, xn, 1024, 512, MP, 1024, -1, 136, EV, wave_s);
#endif
 }
        PHASE_END
        PHASE_BEGIN if (PHMASK & 4u) {
            epi::QMla EQ{(bf16_t*)(g + G_QM), ss_cq, cosT, sinT};
#ifndef NO_A
            run_gemm(lds, (const bf16_t*)(g + G_CQ), 384, (const bf16_t*)(wl + W_UQ), 384, MP, 768, 384, -1, 0, EQ, wave_s);
#endif
            epi::Bf16R EK{(bf16_t*)(g + G_KN), 512, ss_ckv, 1.f / KVLORA};
#ifndef NO_B
            run_gemm(lds, (const bf16_t*)(g + G_CKV), 256, (const bf16_t*)(wl + W_UK), 256, MP, 512, 256, -1, 128, EK, wave_s);
#endif
            epi::Bf16C EV{(bf16_t*)(g + G_VTM), MP, ss_ckv, 1.f / KVLORA};
#ifndef NO_C
            run_gemm(lds, (const bf16_t*)(wl + W_UV), 256, (const bf16_t*)(g + G_CKV), 256, 512, MP, 256, -1, 136, EV, wave_s);
#endif
 }
        PHASE_END
        PHASE_BEGIN if (PHMASK & 8u) att::phase_attention(p, lds, layer, wave_s); PHASE_END
        PHASE_BEGIN if (PHMASK & 16u) {
            epi::Wo E{(float*)(g + G_MIX), ss_osb, ss_oml};
            run_gemm(lds, (const bf16_t*)(g + G_O), 1024, (const bf16_t*)(wl + W_O), 1024, MP, 1024, 1024, 8, 0, E, wave_s); }
        PHASE_END
        PHASE_BEGIN if (PHMASK & 32u) phase_rows(p, (const float*)(g + G_MIX), p.in[11] + layer * DM, p.in[12] + layer * DM, true, wave_s); PHASE_END
        PHASE_BEGIN if (PHMASK & 64u) {
            epi::GateUp E{(bf16_t*)(g + G_ACT)};
            run_gemm(lds, xn, 1024, (const bf16_t*)(wl + W_GU), 1024, MP, NGU, 1024, -1, 0, E, wave_s); }
        PHASE_END
        PHASE_BEGIN if (PHMASK & 128u) {
            epi::F32Out E{(float*)(g + G_FFN)};
            run_gemm(lds, (const bf16_t*)(g + G_ACT), DFF, (const bf16_t*)(wl + W_D), DFF, MP, 1024, DFF, -1, 0, E, wave_s); }
        PHASE_END
        PHASE_BEGIN if (PHMASK & 256u) phase_rows(p, (const float*)(g + G_FFN), p.in[13] + layer * DM, p.in[10] + (layer < 1 ? (layer + 1) * DM : 0), layer < 1, wave_s); PHASE_END
    }
}
constexpr int N_PHASES = 17;

#ifdef DBG_STOP
__global__ void __launch_bounds__(256) dbg_dump(Params p) {
    unsigned char* g = p.ws + WS_G;
    const size_t n = (size_t)TREAL * DM;
    for (size_t i = (size_t)blockIdx.x * 256 + threadIdx.x; i < n; i += (size_t)gridDim.x * 256) {
        const size_t row = i >> 10, c = i & 1023; float v = 0.f;
        auto bf = [](const unsigned char* b, size_t idx) { return __uint_as_float((unsigned)((const bf16_t*)b)[idx] << 16); };
#if DBG_DUMP == 1
        v = bf(g + G_QK, row * 1024 + c) + bf(g + G_CQ, row * 384 + c % 384) + bf(g + G_CKV, row * 256 + c % 256) + bf(g + G_KR, row * 32 + c % 32) + bf(g + G_VTS, (c % 512) * MP + row)
          + ((const float*)(p.ws + WS_SS))[row] + ((const float*)(p.ws + WS_SS))[MP + row];
#elif DBG_DUMP == 2
        v = bf(g + G_QM, row * 768 + c % 768) + bf(g + G_KN, row * 512 + c % 512) + bf(g + G_VTM, (c % 512) * MP + row);
#elif DBG_DUMP == 3
        v = bf(g + G_O, row * 1024 + c);
#elif DBG_DUMP == 31
        v = c < 512 ? bf(g + G_O, row * 1024 + c) : 0.f;
#elif DBG_DUMP == 32
        v = c >= 512 ? bf(g + G_O, row * 1024 + c) : 0.f;
#elif DBG_DUMP == 4
        v = ((const float*)(g + G_MIX))[row * 1024 + c];
#elif DBG_DUMP == 5
        v = bf(p.ws + WS_XN, row * 1024 + c);
#elif DBG_DUMP == 6
        v = bf(g + G_ACT, row * DFF + c) + bf(g + G_ACT, row * DFF + 1024 + c) + bf(g + G_ACT, row * DFF + 1792 + c);
#elif DBG_DUMP == 7
        v = ((const float*)(g + G_FFN))[row * 1024 + c];
#endif
#ifdef DBG_SAN
        if (!(fabsf(v) < 1e30f)) v = 12345.f;
#endif
        p.out[i] = v;
    }
}
#endif

extern "C" void kernel_launch(void* const* d_in, const int* in_sizes, int n_in, void* d_out, int out_size, void* d_ws, size_t ws_size, hipStream_t stream) {
    static int grid = 0;
    if (grid == 0) {
        if (n_in != 17 || ws_size < WS_END) { fprintf(stderr, "kernel_launch: need 17 inputs and %zu bytes of workspace (got %d, %zu)\n", (size_t)WS_END, n_in, ws_size); grid = -1; return; }
        int dev = 0, cus = 0, per_cu = 0;
        (void)hipGetDevice(&dev); (void)hipDeviceGetAttribute(&cus, hipDeviceAttributeMultiprocessorCount, dev);
        (void)hipFuncSetAttribute((const void*)hybrid_fwd, hipFuncAttributeMaxDynamicSharedMemorySize, LDS_BYTES);
        (void)hipOccupancyMaxActiveBlocksPerMultiprocessor(&per_cu, (const void*)hybrid_fwd, NTHR, LDS_BYTES);
        if (per_cu < 1) { fprintf(stderr, "kernel_launch: occupancy query says %d blocks per CU\n", per_cu); per_cu = 1; }
        (void)hipGetLastError();
        grid = cus * 1;
    }
    if (grid < 0) return;
    Params p; memset(&p, 0, sizeof(p));
    for (int i = 0; i < 17; ++i) p.in[i] = (const float*)d_in[i];
    p.out = (float*)d_out; p.ws = (unsigned char*)d_ws;
    for (int i = 0; i < 16; ++i) p.inv_freq[i] = 1.0f / powf(10000.0f, (float)(2 * i) / 32.0f);
#ifndef MK_LAUNCHES
#define MK_LAUNCHES 1
#endif
    if (MK_LAUNCHES == 1) {
        p.ph_lo = 0; p.ph_hi = N_PHASES;
        void* args[] = {&p};
        hipError_t e = hipLaunchCooperativeKernel((const void*)hybrid_fwd, dim3(grid), dim3(NTHR), args, LDS_BYTES, stream);
        if (e != hipSuccess) fprintf(stderr, "cooperative launch failed: %s (grid %d)\n", hipGetErrorString(e), grid);
    } else {
#ifdef DBG_STOP
        for (int k = 0; k < DBG_STOP; ++k) { p.ph_lo = k; p.ph_hi = k + 1; hipLaunchKernelGGL(hybrid_fwd, dim3(grid), dim3(NTHR), LDS_BYTES, stream, p); }
        hipLaunchKernelGGL(dbg_dump, dim3(2048), dim3(256), 0, stream, p);
#else
        for (int k = 0; k < N_PHASES; ++k) { p.ph_lo = k; p.ph_hi = k + 1; hipLaunchKernelGGL(hybrid_fwd, dim3(grid), dim3(NTHR), LDS_BYTES, stream, p); }
#endif
    }
}
```

```cpp
#include <hip/hip_runtime.h>
#include <hip/hip_cooperative_groups.h>
#include <cstdio>
#include <cstdint>
#include <cmath>
#include <cstring>
namespace cg = cooperative_groups;

__device__ __forceinline__ int phase_tid(int wave_s) { int lane; asm volatile("v_mbcnt_lo_u32_b32 %0, -1, 0\n\tv_mbcnt_hi_u32_b32 %0, -1, %0" : "=v"(lane)); return wave_s * 64 + lane; }

namespace pg8 {
#define PG8_LAS __attribute__((address_space(3)))
typedef unsigned short bf16_t;
typedef short bf16x8 __attribute__((ext_vector_type(8)));
typedef float f32x4 __attribute__((ext_vector_type(4)));
typedef unsigned u32x4 __attribute__((ext_vector_type(4)));
constexpr int BM = 256, BK = 64, HALF = 128, HTB = HALF * BK * 2  , STAGE_BYTES = 8 * HTB, NXCD = 8, WGM = 8;

__host__ __device__ __forceinline__ int lds_byte(int r, int c) { const int st = (r >> 4) * 2 + (c >> 5), rr = r & 15, cc = c & 31, ob = rr * 64 + cc * 2; return st * 1024 + (ob ^ (((ob >> 9) & 1) << 5)); }
__host__ __device__ __forceinline__ void stage_rc(int b, int& R, int& C) { const int st = b / 1024, sb = b % 1024, swz = sb ^ (((sb >> 9) & 1) << 5); R = (st >> 1) * 16 + swz / 64; C = (st & 1) * 32 + (swz % 64) / 2; }
__host__ __device__ __forceinline__ int perm32(int rho) { const int n = rho >> 4, i = rho & 15; return 8 * (i >> 2) + 4 * n + (i & 3); }

struct Unit { int pm, pn; };
struct Gemm { const bf16_t* A; const bf16_t* Bt; int M, N, K, lda, ldb, kmid; };

struct StaticOrder {
    int nM, nN, nwg, G, c;
    __host__ __device__ void init(int M, int N, int G_, int c_) { nM = M / BM; nN = N / BM; nwg = nM * nN; G = G_; c = c_; }
    __host__ __device__ bool next(int i, Unit& u) const {
        const long L = (long)i * G + c; if (L >= nwg) return false;
        int wgid = (int)L; { const int q = nwg / NXCD, r = nwg % NXCD, xcd = wgid % NXCD, off = wgid / NXCD; wgid = (xcd < r ? xcd * (q + 1) : r * (q + 1) + (xcd - r) * q) + off; }
        const int nig = WGM * nN, gid = wgid / nig, fm = gid * WGM, gsz = (nM - fm) < WGM ? (nM - fm) : WGM;
        u.pm = fm + ((wgid % nig) % gsz); u.pn = (wgid % nig) / gsz; return true;
    }
    __device__ __forceinline__ void a_ready(const Unit&) const {}
    __device__ __forceinline__ void done(const Unit&) const {}
};


template <class Epi, class Sched, bool ALIGN_EPI = false, bool SP2 = false>
__device__ __forceinline__ void gemm_phase(PG8_LAS unsigned char* lds, const Gemm g, const Sched& S, const Epi& E, const int wave_s) {
    int tid_ = phase_tid(wave_s);
    const int tid = tid_, wid = __builtin_amdgcn_readfirstlane(tid >> 6), lane = tid & 63, wr = wid >> 2, wc = wid & 3, fr = lane & 15, fq = lane >> 4;
    const int K = g.K, nt = K / BK;
    unsigned voffA[2], voffB[2];
#pragma unroll
    for (int i = 0; i < 2; ++i) { int R, C; stage_rc(tid * 16 + i * 8192, R, C); const int Rb = Epi::PERM ? ((R & ~31) + perm32(R & 31)) : R;
        voffA[i] = (unsigned)(R * g.lda + C) * 2u; voffB[i] = (unsigned)(Rb * g.ldb + C) * 2u; }
    const size_t kstep = (size_t)(BK * 2);
    const size_t hstepA = (size_t)HALF * g.lda * 2, hstepB = (size_t)HALF * g.ldb * 2;
    const size_t tstepA = 2 * hstepA, tstepB = 2 * hstepB;
    const unsigned ldsw = (unsigned)wid * 1024u;
    const int aoff = lds_byte(wr * 64 + fr, fq * 8), boff = lds_byte(wc * 32 + fr, fq * 8);
#define PG8_SA(b, h) (((b) * 2 + (h)) * HTB)
#define PG8_SB(b, h) ((4 + (b) * 2 + (h)) * HTB)
#define PG8_STAGE(bufoff, gbase, voff) do { _Pragma("unroll") for (int _i = 0; _i < 2; ++_i) \
        __builtin_amdgcn_global_load_lds((const unsigned*)((const char*)(gbase) + (voff)[_i]), (PG8_LAS unsigned*)(lds + (bufoff) + ldsw + _i * 8192), 16, 0, 0); } while (0)
#define PG8_LDA(dst, b, h) do { _Pragma("unroll") for (int m = 0; m < 4; ++m) _Pragma("unroll") for (int k = 0; k < 2; ++k) dst[m][k] = *(const PG8_LAS bf16x8*)(lds + PG8_SA(b, h) + aoff + m * 2048 + k * 1024); } while (0)
#define PG8_LDB(dst, b, h) do { _Pragma("unroll") for (int n = 0; n < 2; ++n) _Pragma("unroll") for (int k = 0; k < 2; ++k) dst[n][k] = *(const PG8_LAS bf16x8*)(lds + PG8_SB(b, h) + boff + n * 2048 + k * 1024); } while (0)
#define PG8_MMA(ai, bj, At, Bt) do { __builtin_amdgcn_s_setprio(1); _Pragma("unroll") for (int m = 0; m < 4; ++m) _Pragma("unroll") for (int n = 0; n < 2; ++n) _Pragma("unroll") for (int k = 0; k < 2; ++k) \
        acc[ai][bj][m][n] = __builtin_amdgcn_mfma_f32_16x16x32_bf16(Bt[n][k], At[m][k], acc[ai][bj][m][n], 0, 0, 0); __builtin_amdgcn_s_setprio(0); } while (0)
#define PG8_WAIT_V(n) asm volatile("s_waitcnt vmcnt(" #n ")" ::: "memory")
#define PG8_WAIT_L(n) asm volatile("s_waitcnt lgkmcnt(" #n ")" ::: "memory")
#define PG8_BAR __builtin_amdgcn_s_barrier()
#define PG8_SCHED __builtin_amdgcn_sched_barrier(0)
    Unit cur, nxt; int ui = 0;
    if (!S.next(0, cur)) return;
    f32x4 acc[2][2][4][2];
#pragma unroll
    for (int a = 0; a < 2; ++a)
#pragma unroll
        for (int b = 0; b < 2; ++b)
#pragma unroll
            for (int m = 0; m < 4; ++m)
#pragma unroll
                for (int n = 0; n < 2; ++n) acc[a][b][m][n] = (f32x4){0.f, 0.f, 0.f, 0.f};
    bf16x8 At[4][2], B0[2][2], B1[2][2];
    const char* cA = (const char*)g.A + (size_t)cur.pm * tstepA; const char* cB = (const char*)g.Bt + (size_t)cur.pn * tstepB;
    S.a_ready(cur);
    if constexpr (SP2) {
        PG8_STAGE(PG8_SB(0, 0), cB, voffB); PG8_STAGE(PG8_SB(0, 1), cB + hstepB, voffB); PG8_STAGE(PG8_SA(0, 0), cA, voffA); PG8_STAGE(PG8_SA(0, 1), cA + hstepA, voffA);
        if (wr == 1) PG8_BAR;
        PG8_WAIT_V(2); PG8_BAR;
        PG8_STAGE(PG8_SB(1, 0), cB + kstep, voffB); PG8_STAGE(PG8_SA(1, 0), cA + kstep, voffA); PG8_STAGE(PG8_SB(1, 1), cB + hstepB + kstep, voffB);
        PG8_WAIT_V(6); PG8_BAR;
    } else {
        PG8_STAGE(PG8_SB(0, 0), cB, voffB); PG8_STAGE(PG8_SA(0, 0), cA, voffA); PG8_STAGE(PG8_SB(0, 1), cB + hstepB, voffB); PG8_STAGE(PG8_SA(0, 1), cA + hstepA, voffA);
        if (wr == 1) PG8_BAR;
        PG8_WAIT_V(4); PG8_BAR;
        PG8_STAGE(PG8_SB(1, 0), cB + kstep, voffB); PG8_STAGE(PG8_SA(1, 0), cA + kstep, voffA); PG8_STAGE(PG8_SB(1, 1), cB + hstepB + kstep, voffB);
        PG8_WAIT_V(6); PG8_BAR;
    }
    for (;;) {
        const bool has_next = S.next(ui + 1, nxt);
        const char* nA = has_next ? (const char*)g.A + (size_t)nxt.pm * tstepA : cA; const char* nB = has_next ? (const char*)g.Bt + (size_t)nxt.pn * tstepB : cB;
        for (int t = 0; t < nt; t += 2) {
            const bool last = (t == nt - 2);
            if constexpr (Epi::HAS_MID) { if (t == g.kmid) { const int lane_e = phase_tid(0), fr_e = lane_e & 15, fq_e = lane_e >> 4; E.mid(acc, cur, wr, wc, fr_e, fq_e); } }
            const char* a1 = cA + (size_t)(t + 1) * kstep;
            const char* a2 = last ? nA : cA + (size_t)(t + 2) * kstep; const char* b2 = last ? nB : cB + (size_t)(t + 2) * kstep;
            const char* a3 = a2 + kstep; const char* b3 = b2 + kstep;
            if (last && has_next) S.a_ready(nxt);
            if constexpr (SP2) {
            PG8_LDB(B0, 0, 0); PG8_LDB(B1, 0, 1); PG8_SCHED; PG8_LDA(At, 0, 0); PG8_STAGE(PG8_SA(1, 1), a1 + hstepA, voffA);
            PG8_WAIT_V(8); PG8_WAIT_L(0); PG8_BAR; PG8_MMA(0, 0, At, B0); PG8_MMA(0, 1, At, B1); PG8_BAR; PG8_SCHED;
            PG8_LDA(At, 0, 1); PG8_STAGE(PG8_SB(0, 0), b2, voffB); PG8_STAGE(PG8_SB(0, 1), b2 + hstepB, voffB); PG8_STAGE(PG8_SA(0, 0), a2, voffA);
            PG8_WAIT_V(8); PG8_WAIT_L(0); PG8_BAR; PG8_MMA(1, 0, At, B0); PG8_MMA(1, 1, At, B1); PG8_BAR; PG8_SCHED;
            PG8_LDB(B0, 1, 0); PG8_LDB(B1, 1, 1); PG8_SCHED; PG8_LDA(At, 1, 0); PG8_STAGE(PG8_SA(0, 1), a2 + hstepA, voffA);
            PG8_WAIT_V(8); PG8_WAIT_L(0); PG8_BAR; PG8_MMA(0, 0, At, B0); PG8_MMA(0, 1, At, B1); PG8_BAR; PG8_SCHED;
            PG8_LDA(At, 1, 1); PG8_STAGE(PG8_SB(1, 0), b3, voffB); PG8_STAGE(PG8_SB(1, 1), b3 + hstepB, voffB); PG8_STAGE(PG8_SA(1, 0), a3, voffA);
            PG8_WAIT_V(8); PG8_WAIT_L(0); PG8_BAR; PG8_MMA(1, 0, At, B0); PG8_MMA(1, 1, At, B1); PG8_BAR; PG8_SCHED;
            } else {
            PG8_LDB(B0, 0, 0); PG8_SCHED; PG8_LDA(At, 0, 0); PG8_STAGE(PG8_SA(1, 1), a1 + hstepA, voffA);
            PG8_WAIT_L(8); PG8_BAR; PG8_WAIT_L(0); PG8_MMA(0, 0, At, B0); PG8_BAR; PG8_SCHED;
            PG8_LDB(B1, 0, 1); PG8_STAGE(PG8_SB(0, 0), b2, voffB);
            PG8_BAR; PG8_WAIT_L(0); PG8_MMA(0, 1, At, B1); PG8_BAR;
            PG8_LDA(At, 0, 1); PG8_STAGE(PG8_SA(0, 0), a2, voffA);
            PG8_BAR; PG8_WAIT_L(0); PG8_MMA(1, 0, At, B0); PG8_BAR; PG8_SCHED;
            PG8_STAGE(PG8_SB(0, 1), b2 + hstepB, voffB);
            PG8_WAIT_V(6); PG8_BAR; PG8_MMA(1, 1, At, B1); PG8_BAR;
            PG8_LDB(B0, 1, 0); PG8_SCHED; PG8_LDA(At, 1, 0); PG8_STAGE(PG8_SA(0, 1), a2 + hstepA, voffA);
            PG8_WAIT_L(8); PG8_BAR; PG8_WAIT_L(0); PG8_MMA(0, 0, At, B0); PG8_BAR; PG8_SCHED;
            PG8_LDB(B1, 1, 1); PG8_STAGE(PG8_SB(1, 0), b3, voffB);
            PG8_BAR; PG8_WAIT_L(0); PG8_MMA(0, 1, At, B1); PG8_BAR;
            PG8_LDA(At, 1, 1); PG8_STAGE(PG8_SA(1, 0), a3, voffA);
            PG8_BAR; PG8_WAIT_L(0); PG8_MMA(1, 0, At, B0); PG8_BAR; PG8_SCHED;
            PG8_STAGE(PG8_SB(1, 1), b3 + hstepB, voffB);
            PG8_WAIT_V(6); PG8_BAR; PG8_MMA(1, 1, At, B1); PG8_BAR;
            }
        }
        if constexpr (ALIGN_EPI) { if (wr == 0) PG8_BAR; }
        if constexpr (!Epi::AFTER_DRAIN) { const int lane_e = phase_tid(0), fr_e = lane_e & 15, fq_e = lane_e >> 4;
            E(acc, cur, wr, wc, fr_e, fq_e); S.done(cur); }
        if (!has_next) break;
#pragma unroll
        for (int a = 0; a < 2; ++a)
#pragma unroll
            for (int b = 0; b < 2; ++b)
#pragma unroll
                for (int m = 0; m < 4; ++m)
#pragma unroll
                    for (int n = 0; n < 2; ++n) acc[a][b][m][n] = (f32x4){0.f, 0.f, 0.f, 0.f};
        cur = nxt; cA = nA; cB = nB; ++ui;
        if constexpr (ALIGN_EPI) { if (wr == 1) PG8_BAR; }
    }
    PG8_WAIT_V(0);
    if constexpr (!ALIGN_EPI) { if (wr == 0) PG8_BAR; }
    PG8_BAR;
    if constexpr (Epi::AFTER_DRAIN) { E.fused(acc, cur, wr, wc, fr, fq, lds, wid, lane); S.done(cur); }
#undef PG8_SA
#undef PG8_SB
#undef PG8_STAGE
#undef PG8_LDA
#undef PG8_LDB
#undef PG8_MMA
#undef PG8_WAIT_V
#undef PG8_WAIT_L
#undef PG8_BAR
#undef PG8_SCHED
}
}


#define LAS __attribute__((address_space(3)))
typedef unsigned short bf16_t;
typedef short bf16x8 __attribute__((ext_vector_type(8)));
typedef float f32x4 __attribute__((ext_vector_type(4)));
typedef float f32x16 __attribute__((ext_vector_type(16)));
typedef unsigned u32x4 __attribute__((ext_vector_type(4)));
typedef unsigned u32x2 __attribute__((ext_vector_type(2)));

constexpr int NB = 8, SEQ = 4096, NMETA = 16, DM = 1024, TREAL = NB * SEQ, TTOT = TREAL + NB * NMETA, MP = 33024, LPOS = SEQ + NMETA;
constexpr int NMAIN = 1792, DFF = 2816, NGU = 2 * DFF, QLORA = 384, KVLORA = 256;
constexpr float EPS = 1e-6f;
constexpr int NTHR = 512, NWAVE = 8;
constexpr int LDS_BYTES = 131072;

constexpr size_t al256(size_t x) { return (x + 255) & ~(size_t)255; }
constexpr size_t WS_ROPE = 0;
constexpr size_t ROPE_BYTES = al256(2ull * LPOS * 16 * 4);
constexpr size_t WS_SS = WS_ROPE + ROPE_BYTES;
constexpr size_t SS_FLOATS = 2ull * 4 * MP;
constexpr size_t WS_HMETA = WS_SS + al256(SS_FLOATS * 4);
constexpr size_t WS_W = WS_HMETA + 256ull * 1024 * 4;
constexpr size_t W_MAIN = 0, W_V = W_MAIN + 1792ull * 1024 * 2, W_UQ = W_V + 512ull * 1024 * 2, W_UK = W_UQ + 768ull * 384 * 2, W_UV = W_UK + 512ull * 256 * 2,
                 W_O = W_UV + 512ull * 256 * 2, W_GU = W_O + 1024ull * 1024 * 2, W_D = W_GU + 5632ull * 1024 * 2, W_LAYER = W_D + 1024ull * 2816 * 2;
constexpr size_t WS_XN = WS_W + 2 * W_LAYER;
constexpr size_t WS_G = WS_XN + (size_t)MP * 1024 * 2;
constexpr size_t G_QK = 0, G_CQ = G_QK + (size_t)MP * 1024 * 2, G_CKV = G_CQ + (size_t)MP * 384 * 2, G_KR = G_CKV + (size_t)MP * 256 * 2, G_VTS = G_KR + (size_t)MP * 32 * 2,
                 G_QM = G_VTS + 512ull * MP * 2, G_KN = G_QM + (size_t)MP * 768 * 2, G_VTM = G_KN + (size_t)MP * 512 * 2, G_O = G_VTM + 512ull * MP * 2, G_END = G_O + (size_t)MP * 1024 * 2;
constexpr size_t G_MIX = 0, G_ACT = 0, G_FFN = G_ACT + (size_t)MP * DFF * 2;
static_assert(G_MIX + (size_t)MP * 1024 * 4 <= G_QM, "mix overlays only dead buffers");
static_assert(G_FFN + (size_t)MP * 1024 * 4 <= G_END, "ffn inside group");
constexpr size_t WS_END = WS_G + G_END;

struct Params {
    const float* in[17];
    float* out; unsigned char* ws;
    float inv_freq[16];
    int ph_lo, ph_hi;
};

typedef __bf16 bf16x2_t __attribute__((ext_vector_type(2)));
typedef float f32x2_t __attribute__((ext_vector_type(2)));
__device__ __forceinline__ unsigned pk_bf16(float lo, float hi) { const f32x2_t v = {lo, hi}; const bf16x2_t b = __builtin_convertvector(v, bf16x2_t); return __builtin_bit_cast(unsigned, b); }
__device__ __forceinline__ float wave_sum(float v) {
#pragma unroll
    for (int o = 1; o < 64; o <<= 1) v += __shfl_xor(v, o);
    return v;
}
__device__ __forceinline__ int row_pos(int row) { return row < TREAL ? NMETA + (row & (SEQ - 1)) : ((row - TREAL) & (NMETA - 1)); }

namespace epi {
using pg8::Unit;
typedef const f32x4 (&AccC)[2][2][4][2];
typedef f32x4 (&AccM)[2][2][4][2];

struct Main {
    static constexpr bool PERM = false, AFTER_DRAIN = false, HAS_MID = false;
    bf16_t *qk, *cq, *ckv, *kr; float *ss_cq, *ss_ckv; const float *cosT, *sinT;
    template <int BJ, int MODE, bool SS>
    __device__ __forceinline__ void half(AccC acc, bf16_t* dst, int ldc, int c0, float* ss, int rbase, int fq) const {
#pragma unroll
        for (int ai = 0; ai < 2; ++ai)
#pragma unroll
            for (int m = 0; m < 4; ++m) {
                const int row = rbase + ai * 128 + m * 16;
                f32x4 v0 = acc[ai][BJ][m][0], v1 = acc[ai][BJ][m][1];
                if (MODE == 1) {
                    const int pos = row_pos(row);
                    const f32x4 c = *(const f32x4*)(cosT + pos * 16 + 4 * fq), s = *(const f32x4*)(sinT + pos * 16 + 4 * fq);
                    const f32x4 a = v0 * c - v1 * s, b = v1 * c + v0 * s; v0 = a; v1 = b;
                }
                bf16_t* p = dst + (size_t)row * ldc + c0;
                *(u32x2*)p = (u32x2){pk_bf16(v0[0], v0[1]), pk_bf16(v0[2], v0[3])};
                *(u32x2*)(p + 16) = (u32x2){pk_bf16(v1[0], v1[1]), pk_bf16(v1[2], v1[3])};
                if (SS) {
                    float s = (v0[0] * v0[0] + v0[1] * v0[1]) + (v0[2] * v0[2] + v0[3] * v0[3]) + (v1[0] * v1[0] + v1[1] * v1[1]) + (v1[2] * v1[2] + v1[3] * v1[3]);
                    s += __shfl_xor(s, 16); s += __shfl_xor(s, 32);
                    if (fq == 0) atomicAdd(ss + row, s);
                }
            }
    }
    __device__ __forceinline__ void operator()(AccC acc, const Unit& u, int wr, int wc, int fr, int fq) const {
        const int pn = u.pn, rbase = u.pm * 256 + wr * 64 + fr, cb = 32 * wc + 4 * fq;
        if (pn < 4) { half<0, 0, false>(acc, qk, 1024, pn * 256 + cb, nullptr, rbase, fq); half<1, 0, false>(acc, qk, 1024, pn * 256 + 128 + cb, nullptr, rbase, fq); }
        else if (pn == 4) { half<0, 0, true>(acc, cq, 384, cb, ss_cq, rbase, fq); half<1, 0, true>(acc, cq, 384, 128 + cb, ss_cq, rbase, fq); }
        else if (pn == 5) { half<0, 0, true>(acc, cq, 384, 256 + cb, ss_cq, rbase, fq); half<1, 0, true>(acc, ckv, 256, cb, ss_ckv, rbase, fq); }
        else { half<0, 0, true>(acc, ckv, 256, 128 + cb, ss_ckv, rbase, fq); if (wc == 0) half<1, 1, false>(acc, kr, 32, 4 * fq, nullptr, rbase, fq); }
    }
};
struct Bf16R {
    static constexpr bool PERM = false, AFTER_DRAIN = false, HAS_MID = false;
    bf16_t* O; int ldc; const float* ss_row; float invn_row;
    __device__ __forceinline__ void operator()(AccC acc, const Unit& u, int wr, int wc, int fr, int fq) const {
        const int rbase = u.pm * 256 + wr * 64 + fr, cbase = u.pn * 256 + 32 * wc + 4 * fq;
#pragma unroll
        for (int ai = 0; ai < 2; ++ai)
#pragma unroll
            for (int m = 0; m < 4; ++m) {
                const int row = rbase + ai * 128 + m * 16;
                const float rs = ss_row ? __builtin_amdgcn_rsqf(ss_row[row] * invn_row + EPS) : 1.f;
#pragma unroll
                for (int bj = 0; bj < 2; ++bj)
#pragma unroll
                    for (int n = 0; n < 2; ++n) {
                        const f32x4 v = acc[ai][bj][m][n] * rs;
                        *(u32x2*)(O + (size_t)row * ldc + cbase + bj * 128 + n * 16) = (u32x2){pk_bf16(v[0], v[1]), pk_bf16(v[2], v[3])};
                    }
                asm volatile("" ::: "memory");
            }
    }
};
struct Bf16C {
    static constexpr bool PERM = false, AFTER_DRAIN = false, HAS_MID = false;
    bf16_t* O; int ldc; const float* ss_col; float invn_col;
    __device__ __forceinline__ void operator()(AccC acc, const Unit& u, int wr, int wc, int fr, int fq) const {
        const int rbase = u.pm * 256 + wr * 64 + fr, cbase = u.pn * 256 + 32 * wc + 4 * fq;
#pragma unroll
        for (int bj = 0; bj < 2; ++bj)
#pragma unroll
            for (int n = 0; n < 2; ++n) {
                const f32x4 q = *(const f32x4*)(ss_col + cbase + bj * 128 + n * 16); f32x4 cs;
#pragma unroll
                for (int i = 0; i < 4; ++i) cs[i] = __builtin_amdgcn_rsqf(q[i] * invn_col + EPS);
#pragma unroll
                for (int ai = 0; ai < 2; ++ai)
#pragma unroll
                    for (int m = 0; m < 4; ++m) {
                        const int row = rbase + ai * 128 + m * 16;
                        const f32x4 v = acc[ai][bj][m][n] * cs;
                        *(u32x2*)(O + (size_t)row * ldc + cbase + bj * 128 + n * 16) = (u32x2){pk_bf16(v[0], v[1]), pk_bf16(v[2], v[3])};
                    }
                asm volatile("" ::: "memory");
            }
    }
};
struct QMla {
    static constexpr bool PERM = false, AFTER_DRAIN = false, HAS_MID = false;
    bf16_t* O; const float* ss; const float *cosT, *sinT;
    __device__ __forceinline__ void operator()(AccC acc, const Unit& u, int wr, int wc, int fr, int fq) const {
        const int rbase = u.pm * 256 + wr * 64 + fr;
#pragma unroll
        for (int ai = 0; ai < 2; ++ai)
#pragma unroll
            for (int m = 0; m < 4; ++m) {
                const int row = rbase + ai * 128 + m * 16;
                const float rs = __builtin_amdgcn_rsqf(ss[row] * (1.f / QLORA) + EPS);
                const int pos = row_pos(row);
#pragma unroll
                for (int bj = 0; bj < 2; ++bj) {
                    const int colg = u.pn * 256 + bj * 128 + 32 * wc;
                    f32x4 v0 = acc[ai][bj][m][0] * rs, v1 = acc[ai][bj][m][1] * rs;
                    if (((colg >> 5) % 3) == 2) {
                        const f32x4 c = *(const f32x4*)(cosT + pos * 16 + 4 * fq), s = *(const f32x4*)(sinT + pos * 16 + 4 * fq);
                        const f32x4 a = v0 * c - v1 * s, b = v1 * c + v0 * s; v0 = a; v1 = b;
                    }
                    bf16_t* p = O + (size_t)row * 768 + colg + 4 * fq;
                    *(u32x2*)p = (u32x2){pk_bf16(v0[0], v0[1]), pk_bf16(v0[2], v0[3])};
                    *(u32x2*)(p + 16) = (u32x2){pk_bf16(v1[0], v1[1]), pk_bf16(v1[2], v1[3])};
                }
                asm volatile("" ::: "memory");
            }
    }
};
struct Wo {
    static constexpr bool PERM = false, AFTER_DRAIN = false, HAS_MID = true;
    float* O; const float *ss_sb, *ss_mla;
    __device__ __forceinline__ void mid(AccM acc, const Unit& u, int wr, int wc, int fr, int fq) const {
        int rbase = u.pm * 256 + wr * 64 + fr; asm volatile("" : "+v"(rbase) :: "memory");
#pragma unroll
        for (int ai = 0; ai < 2; ++ai)
#pragma unroll
            for (int m = 0; m < 4; ++m) {
                const int row = rbase + ai * 128 + m * 16;
                const float r = __builtin_amdgcn_rsqf(ss_sb[row] * (1.f / 512) + EPS) * __builtin_amdgcn_sqrtf(ss_mla[row] * (1.f / 512) + EPS);
#pragma unroll
                for (int bj = 0; bj < 2; ++bj)
#pragma unroll
                    for (int n = 0; n < 2; ++n) acc[ai][bj][m][n] *= r;
            }
    }
    __device__ __forceinline__ void operator()(AccC acc, const Unit& u, int wr, int wc, int fr, int fq) const {
        const int rbase = u.pm * 256 + wr * 64 + fr, cbase = u.pn * 256 + 32 * wc + 4 * fq;
#pragma unroll
        for (int ai = 0; ai < 2; ++ai)
#pragma unroll
            for (int m = 0; m < 4; ++m) {
                const int row = rbase + ai * 128 + m * 16;
                const float r = __builtin_amdgcn_rsqf(ss_mla[row] * (1.f / 512) + EPS);
#pragma unroll
                for (int bj = 0; bj < 2; ++bj)
#pragma unroll
                    for (int n = 0; n < 2; ++n) *(f32x4*)(O + (size_t)row * 1024 + cbase + bj * 128 + n * 16) = acc[ai][bj][m][n] * r;
            }
    }
};
struct GateUp {
    static constexpr bool PERM = false, AFTER_DRAIN = false, HAS_MID = false;
    bf16_t* O;
    __device__ __forceinline__ void operator()(AccC acc, const Unit& u, int wr, int wc, int fr, int fq) const {
        const int rbase = u.pm * 256 + wr * 64 + fr, cbase = u.pn * 128 + 16 * wc + 4 * fq;
#pragma unroll
        for (int ai = 0; ai < 2; ++ai)
#pragma unroll
            for (int m = 0; m < 4; ++m) {
                const int row = rbase + ai * 128 + m * 16;
#pragma unroll
                for (int bj = 0; bj < 2; ++bj) {
                    const f32x4 g = acc[ai][bj][m][0], up = acc[ai][bj][m][1]; f32x4 a;
#pragma unroll
                    for (int i = 0; i < 4; ++i) a[i] = g[i] * __builtin_amdgcn_rcpf(1.f + __builtin_amdgcn_exp2f(-1.44269504089f * g[i])) * up[i];
                    *(u32x2*)(O + (size_t)row * DFF + cbase + bj * 64) = (u32x2){pk_bf16(a[0], a[1]), pk_bf16(a[2], a[3])};
                }
            }
    }
};
struct F32Out {
    static constexpr bool PERM = false, AFTER_DRAIN = false, HAS_MID = false;
    float* O;
    __device__ __forceinline__ void operator()(AccC acc, const Unit& u, int wr, int wc, int fr, int fq) const {
        const int rbase = u.pm * 256 + wr * 64 + fr, cbase = u.pn * 256 + 32 * wc + 4 * fq;
#pragma unroll
        for (int ai = 0; ai < 2; ++ai)
#pragma unroll
            for (int m = 0; m < 4; ++m) {
                const int row = rbase + ai * 128 + m * 16;
#pragma unroll
                for (int bj = 0; bj < 2; ++bj)
#pragma unroll
                    for (int n = 0; n < 2; ++n) *(f32x4*)(O + (size_t)row * 1024 + cbase + bj * 128 + n * 16) = acc[ai][bj][m][n];
            }
    }
};
}

template <class Epi>
__device__ __forceinline__ void run_gemm(LAS unsigned char* lds, const bf16_t* A, int lda, const bf16_t* Bt, int ldb, int M, int N, int K, int kmid, int rot, const Epi& E, int wave_s) {
    pg8::Gemm g{A, Bt, M, N, K, lda, ldb, kmid};
    int bx = (int)blockIdx.x, G = (int)gridDim.x; asm volatile("" : "+s"(bx), "+s"(G));
    pg8::StaticOrder S; S.init(M, N, G, (bx + G - (rot % G)) % G);
    pg8::gemm_phase<Epi, pg8::StaticOrder, true, true>(lds, g, S, E, wave_s);
}

__device__ __forceinline__ void tr_item(const float* W, int ldw, int scol0, int k0, const float* kg0, const float* kg1, float scale, bf16_t* WT, int K, int drow0, int mode, LAS float* scr, int lane) {
#pragma unroll 8
    for (int i = 0; i < 32; ++i) {
        const int kk = 2 * i + (lane >> 5), k = k0 + kk; float g = scale;
        if (kg0) g *= (kg1 && k >= 512) ? kg1[k - 512] : kg0[k];
        scr[kk * 33 + (lane & 31)] = W[(size_t)k * ldw + scol0 + (lane & 31)] * g;
    }
    asm volatile("s_waitcnt lgkmcnt(0)" ::: "memory");
    const int c = lane & 7;
#pragma unroll
    for (int j = 0; j < 4; ++j) {
        const int n = (lane >> 3) + 8 * j; const LAS float* s = scr + (8 * c) * 33 + n;
        u32x4 o; o.x = pk_bf16(s[0 * 33], s[1 * 33]); o.y = pk_bf16(s[2 * 33], s[3 * 33]); o.z = pk_bf16(s[4 * 33], s[5 * 33]); o.w = pk_bf16(s[6 * 33], s[7 * 33]);
        const int drow = drow0 + (mode ? 32 * (n >> 4) + (n & 15) : n);
        *(u32x4*)(WT + (size_t)drow * K + k0 + 8 * c) = o;
    }
    asm volatile("s_waitcnt lgkmcnt(0)" ::: "memory");
}

constexpr float SCALE_QMLA = 0.10206207261596575f * 1.4426950408889634f;
constexpr int ITEMS_PER_LAYER = 6112;

__device__ __forceinline__ void convert_item(const Params& p, int layer, int it, LAS float* scr, int lane) {
    unsigned char* wl = p.ws + WS_W + (size_t)layer * W_LAYER;
    const float* w_in = p.in[2] + (size_t)layer * 1024 * 2208;
    constexpr int IT_SEG[12] = {0, 256, 512, 768, 1104, 1248, 1312, 1376, 1888, 3296, 4704, 6112};
    int seg = 0;
#pragma unroll
    for (int s = 1; s < 11; ++s) if (it >= IT_SEG[s]) seg = s;
    const int r = it - IT_SEG[seg];
    switch (seg) {
    case 0: { const int nb = r % 16, kb = r / 16; tr_item(w_in, 2208, 32 * nb, 64 * kb, nullptr, nullptr, 0.125f, (bf16_t*)(wl + W_MAIN), 1024, 32 * nb, 0, scr, lane); break; }
    case 1: { const int nb = r % 16, kb = r / 16; tr_item(w_in, 2208, 512 + 32 * nb, 64 * kb, nullptr, nullptr, 1.f, (bf16_t*)(wl + W_MAIN), 1024, 512 + 32 * nb, 0, scr, lane); break; }
    case 2: { const int nb = r % 16, kb = r / 16; tr_item(w_in, 2208, 1024 + 32 * nb, 64 * kb, nullptr, nullptr, 1.f, (bf16_t*)(wl + W_V), 1024, 32 * nb, 0, scr, lane); break; }
    case 3: { const int nb = r % 21, kb = r / 21; tr_item(w_in, 2208, 1536 + 32 * nb, 64 * kb, nullptr, nullptr, 1.f, (bf16_t*)(wl + W_MAIN), 1024, 1024 + 32 * nb, 0, scr, lane); break; }
    case 4: { const int nb = r % 24, kb = r / 24; tr_item(p.in[5] + (size_t)layer * 384 * 768, 768, 32 * nb, 64 * kb, p.in[3] + layer * 384, nullptr, SCALE_QMLA, (bf16_t*)(wl + W_UQ), 384, 32 * nb, 0, scr, lane); break; }
    case 5: { const int nb = r % 16, kb = r / 16; const int n0 = 32 * nb; tr_item(p.in[6] + (size_t)layer * 256 * 1024, 1024, 128 * (n0 >> 6) + (n0 & 63), 64 * kb, p.in[4] + layer * 256, nullptr, 1.f, (bf16_t*)(wl + W_UK), 256, n0, 0, scr, lane); break; }
    case 6: { const int nb = r % 16, kb = r / 16; const int n0 = 32 * nb; tr_item(p.in[6] + (size_t)layer * 256 * 1024, 1024, 128 * (n0 >> 6) + 64 + (n0 & 63), 64 * kb, p.in[4] + layer * 256, nullptr, 1.f, (bf16_t*)(wl + W_UV), 256, n0, 0, scr, lane); break; }
    case 7: { const int nb = r % 32, kb = r / 32; tr_item(p.in[9] + (size_t)layer * 1024 * 1024, 1024, 32 * nb, 64 * kb, p.in[7] + layer * 512, p.in[8] + layer * 512, 1.f, (bf16_t*)(wl + W_O), 1024, 32 * nb, 0, scr, lane); break; }
    case 8: { const int nb = r % 88, kb = r / 88; tr_item(p.in[14] + (size_t)layer * 1024 * DFF, DFF, 32 * nb, 64 * kb, nullptr, nullptr, 1.f, (bf16_t*)(wl + W_GU), 1024, 64 * nb, 1, scr, lane); break; }
    case 9: { const int nb = r % 88, kb = r / 88; tr_item(p.in[15] + (size_t)layer * 1024 * DFF, DFF, 32 * nb, 64 * kb, nullptr, nullptr, 1.f, (bf16_t*)(wl + W_GU), 1024, 64 * nb + 16, 1, scr, lane); break; }
    default: { const int nb = r % 32, kb = r / 32; tr_item(p.in[16] + (size_t)layer * DFF * 1024, 1024, 32 * nb, 64 * kb, nullptr, nullptr, 1.f, (bf16_t*)(wl + W_D), DFF, 32 * nb, 0, scr, lane); break; }
    }
}

__device__ __forceinline__ void sincos_f64(double a, double& s, double& c) {
    const double k = rint(a * 0.63661977236758134308);
    double r = fma(-k, 1.57079632679489655800e+00, a); r = fma(-k, 6.12323399573676603587e-17, r);
    const double r2 = r * r;
    double sp = -1.0 / 1307674368000.0; sp = fma(sp, r2, 1.0 / 6227020800.0); sp = fma(sp, r2, -1.0 / 39916800.0); sp = fma(sp, r2, 1.0 / 362880.0); sp = fma(sp, r2, -1.0 / 5040.0); sp = fma(sp, r2, 1.0 / 120.0); sp = fma(sp, r2, -1.0 / 6.0);
    const double sr = fma(sp * r2, r, r);
    double cp = 1.0 / 20922789888000.0; cp = fma(cp, r2, -1.0 / 87178291200.0); cp = fma(cp, r2, 1.0 / 479001600.0); cp = fma(cp, r2, -1.0 / 3628800.0); cp = fma(cp, r2, 1.0 / 40320.0); cp = fma(cp, r2, -1.0 / 720.0); cp = fma(cp, r2, 1.0 / 24.0); cp = fma(cp, r2, -0.5);
    const double cr = fma(cp, r2, 1.0);
    const int q = ((int)k) & 3;
    s = (q == 0) ? sr : (q == 1) ? cr : (q == 2) ? -sr : -cr;
    c = (q == 0) ? cr : (q == 1) ? -sr : (q == 2) ? -cr : sr;
}

__device__ __forceinline__ void row_step(const float* y, const float* gy, float* hrow, const float* hsrc, const float* gx, bf16_t* xn, int lane) {
    f32x4 v[4];
#pragma unroll
    for (int j = 0; j < 4; ++j) v[j] = *((const f32x4*)hsrc + lane + 64 * j);
    if (y) {
        f32x4 t[4]; float s = 0.f;
#pragma unroll
        for (int j = 0; j < 4; ++j) { t[j] = *((const f32x4*)y + lane + 64 * j); s += (t[j][0] * t[j][0] + t[j][1] * t[j][1]) + (t[j][2] * t[j][2] + t[j][3] * t[j][3]); }
        const float rs = 1.0f / sqrtf(wave_sum(s) * (1.f / DM) + EPS);
#pragma unroll
        for (int j = 0; j < 4; ++j) { const f32x4 g = *((const f32x4*)gy + lane + 64 * j); v[j] += t[j] * rs * g; }
    }
#pragma unroll
    for (int j = 0; j < 4; ++j) *((f32x4*)hrow + lane + 64 * j) = v[j];
    if (xn) {
        float s = 0.f;
#pragma unroll
        for (int j = 0; j < 4; ++j) s += (v[j][0] * v[j][0] + v[j][1] * v[j][1]) + (v[j][2] * v[j][2] + v[j][3] * v[j][3]);
        const float rs = 1.0f / sqrtf(wave_sum(s) * (1.f / DM) + EPS);
#pragma unroll
        for (int j = 0; j < 4; ++j) { const f32x4 g = *((const f32x4*)gx + lane + 64 * j); const f32x4 o = v[j] * rs * g;
            *((u32x2*)xn + lane + 64 * j) = (u32x2){pk_bf16(o[0], o[1]), pk_bf16(o[2], o[3])}; }
    }
}
__device__ __forceinline__ float* h_row(const Params& p, int row) { return row < TREAL ? p.out + (size_t)row * DM : (float*)(p.ws + WS_HMETA) + (size_t)(row - TREAL) * DM; }

__device__ __forceinline__ void phase_prologue(const Params& p, LAS unsigned char* lds, int wave_s) {
    int tid_ = phase_tid(wave_s);
    const int tid = tid_, lane = tid & 63, wave = tid >> 6, G = gridDim.x;
    const int gt = blockIdx.x * NTHR + tid, NGT = G * NTHR, gw = blockIdx.x * NWAVE + wave, NGW = G * NWAVE;
    float* ss = (float*)(p.ws + WS_SS);
    for (size_t i = gt; i < SS_FLOATS; i += NGT) ss[i] = 0.f;
    float* cosT = (float*)(p.ws + WS_ROPE); float* sinT = cosT + LPOS * 16;
    for (int i = gt; i < LPOS * 16; i += NGT) { const int pos = i >> 4, j = i & 15; const float ang = (float)pos * p.inv_freq[j]; double s, c; sincos_f64((double)ang, s, c); cosT[i] = (float)c; sinT[i] = (float)s; }
    for (int l = 0; l < 2; ++l) {
        u32x4* z = (u32x4*)(p.ws + WS_W + (size_t)l * W_LAYER + W_MAIN + 1696ull * 1024 * 2);
        for (int i = gt; i < 96 * 1024 * 2 / 16; i += NGT) z[i] = (u32x4){0u, 0u, 0u, 0u};
    }
    LAS float* scr = (LAS float*)(lds + wave * 16384);
    for (int it = gw; it < 2 * ITEMS_PER_LAYER; it += NGW) { const int layer = it >= ITEMS_PER_LAYER ? 1 : 0; convert_item(p, layer, it - layer * ITEMS_PER_LAYER, scr, lane); }
    bf16_t* xn = (bf16_t*)(p.ws + WS_XN);
    for (int row = gw; row < TTOT; row += NGW) {
        const float* src = row < TREAL ? p.in[0] + (size_t)row * DM : p.in[1] + (size_t)((row - TREAL) & 15) * DM;
        row_step(nullptr, nullptr, h_row(p, row), src, p.in[10], xn + (size_t)row * DM, lane);
    }
}
__device__ __forceinline__ void phase_rows(const Params& p, const float* y, const float* gy, const float* gx, bool make_xn, int nrows, int wave_s) {
    int tid_ = phase_tid(wave_s);
    const int tid = tid_, lane = tid & 63, wave = tid >> 6, gw = blockIdx.x * NWAVE + wave, NGW = gridDim.x * NWAVE;
    bf16_t* xn = (bf16_t*)(p.ws + WS_XN);
    for (int row = gw; row < nrows; row += NGW) { float* h = h_row(p, row); row_step(y + (size_t)row * DM, gy, h, h, gx, make_xn ? xn + (size_t)row * DM : nullptr, lane); }
}

namespace att {
constexpr int KS_SB = 144, KS_ML = 208, VS = 144;
constexpr int KB0 = 0, KBSZ = 64 * KS_ML, VB0 = 2 * KBSZ, VBSZ = 64 * VS, FLG = VB0 + 2 * VBSZ;
__device__ __forceinline__ int pi_row(int m) { return 16 * (m >> 4) + 8 * ((m >> 2) & 1) + 4 * ((m >> 3) & 1) + (m & 3); }
#define MFMA32(a, b, c) __builtin_amdgcn_mfma_f32_32x32x16_bf16(a, b, c, 0, 0, 0)
__device__ __forceinline__ bf16x8 pack8(const f32x16& s, int o) {
    u32x4 w; w.x = pk_bf16(s[o + 0], s[o + 1]); w.y = pk_bf16(s[o + 2], s[o + 3]); w.z = pk_bf16(s[o + 4], s[o + 5]); w.w = pk_bf16(s[o + 6], s[o + 7]);
    return __builtin_bit_cast(bf16x8, w);
}
__device__ __forceinline__ void store_o(const f32x16& o0, const f32x16& o1, float inv, bf16_t* orow, float* ssrow, int hi, bool valid) {
    float ssq = 0.f;
#pragma unroll
    for (int db = 0; db < 2; ++db)
#pragma unroll
        for (int a = 0; a < 4; ++a) {
            const f32x16& o = db ? o1 : o0;
            const float v0 = o[4 * a] * inv, v1 = o[4 * a + 1] * inv, v2 = o[4 * a + 2] * inv, v3 = o[4 * a + 3] * inv;
            ssq += (v0 * v0 + v1 * v1) + (v2 * v2 + v3 * v3);
            if (valid) *(u32x2*)(orow + 32 * db + 8 * a + 4 * hi) = (u32x2){pk_bf16(v0, v1), pk_bf16(v2, v3)};
        }
    ssq += __shfl_xor(ssq, 32);
    if (valid && hi == 0) atomicAdd(ssrow, ssq);
}

__device__ __forceinline__ void mla_unit(int wave_s, LAS unsigned char* lds, const bf16_t* Q, const bf16_t* Kn, const bf16_t* Kr, const bf16_t* VT, bf16_t* O, float* ss, int b, int h, int qb) {
    int tid_ = phase_tid(wave_s);
    const int tid = tid_, lane = tid & 63, w = __builtin_amdgcn_readfirstlane(tid >> 6), ql = lane & 31, hi = lane >> 5;
    const bool meta = qb < 0;
    const int qrow = meta ? (TREAL + b * 16 + (ql & 15)) : (b * SEQ + qb * 256 + w * 32 + ql);
    const int qt = meta ? ql : (qb * 256 + w * 32 + ql);
    bf16x8 qf[6];
#pragma unroll
    for (int ks = 0; ks < 6; ++ks) qf[ks] = *(const bf16x8*)(Q + (size_t)qrow * 768 + h * 96 + (2 * ks + hi) * 8);
    const int ntiles = meta ? 1 : 4 * qb + 5;
    const int wlast = meta ? (w == 0 ? 0 : -1) : 1 + 4 * qb + (w >> 1);
    const int krow = tid >> 3, kch = tid & 7, rrow = tid >> 2, rch = tid & 3;
    const unsigned aoff = (unsigned)(pi_row(ql) * KS_ML + hi * 16), voff = (unsigned)(ql * VS + hi * 16);
    float mrun = -INFINITY, lrun = 0.f;
    f32x16 o0, o1;
#pragma unroll
    for (int i = 0; i < 16; ++i) { o0[i] = 0.f; o1[i] = 0.f; }
    u32x4 rk, rr = (u32x4){0u, 0u, 0u, 0u}, rv;
    auto gload = [&](int i) {
        const int row0 = (i == 0) ? TREAL + b * 16 : b * SEQ + 64 * (i - 1);
        rk = *(const u32x4*)(Kn + (size_t)(row0 + krow) * 512 + h * 64 + kch * 8);
        if (tid < 256) rr = *(const u32x4*)(Kr + (size_t)(row0 + rrow) * 32 + rch * 8);
        rv = *(const u32x4*)(VT + (size_t)(h * 64 + krow) * MP + row0 + kch * 8);
    };
    auto lstore = [&](int buf) {
        *(LAS u32x4*)(lds + KB0 + buf * KBSZ + krow * KS_ML + kch * 16) = rk;
        if (tid < 256) *(LAS u32x4*)(lds + KB0 + buf * KBSZ + rrow * KS_ML + 128 + rch * 16) = rr;
        *(LAS u32x4*)(lds + VB0 + buf * VBSZ + krow * VS + kch * 16) = rv;
    };
    gload(0); lstore(0); __syncthreads();
    for (int i = 0; i < ntiles; ++i) {
        const int buf = i & 1;
        if (i + 1 < ntiles) gload(i + 1);
        if (i <= wlast) {
            const LAS unsigned char* kb = lds + KB0 + buf * KBSZ + aoff; const LAS unsigned char* vb = lds + VB0 + buf * VBSZ + voff;
            f32x16 s0, s1;
#pragma unroll
            for (int r = 0; r < 16; ++r) { s0[r] = 0.f; s1[r] = 0.f; }
#pragma unroll
            for (int ks = 0; ks < 6; ++ks) {
                const bf16x8 a0 = *(const LAS bf16x8*)(kb + ks * 32), a1 = *(const LAS bf16x8*)(kb + 32 * KS_ML + ks * 32);
                s0 = MFMA32(a0, qf[ks], s0); s1 = MFMA32(a1, qf[ks], s1);
            }
            const int lim = (i == 0) ? (meta ? (ql < 15 ? ql : 15) : 15) : qt - 64 * (i - 1);
            if (__ballot(lim < 63) != 0ull) {
#pragma unroll
                for (int r = 0; r < 16; ++r) { const int ki = 16 * (r >> 3) + 8 * hi + (r & 7); if (ki > lim) s0[r] = -INFINITY; if (ki + 32 > lim) s1[r] = -INFINITY; }
            }
            float mx = fmaxf(s0[0], s1[0]);
#pragma unroll
            for (int r = 1; r < 16; ++r) mx = fmaxf(mx, fmaxf(s0[r], s1[r]));
            mx = fmaxf(mx, __shfl_xor(mx, 32));
            const float mn = fmaxf(mrun, mx), alpha = __builtin_amdgcn_exp2f(mrun - mn); mrun = mn;
            float rs = 0.f;
#pragma unroll
            for (int r = 0; r < 16; ++r) { s0[r] = __builtin_amdgcn_exp2f(s0[r] - mn); s1[r] = __builtin_amdgcn_exp2f(s1[r] - mn); rs += s0[r] + s1[r]; }
            lrun = lrun * alpha + rs;
#pragma unroll
            for (int r = 0; r < 16; ++r) { o0[r] *= alpha; o1[r] *= alpha; }
#pragma unroll
            for (int s = 0; s < 4; ++s) {
                const bf16x8 pf = pack8((s >> 1) ? s1 : s0, 8 * (s & 1));
                const bf16x8 v0 = *(const LAS bf16x8*)(vb + s * 32), v1 = *(const LAS bf16x8*)(vb + 32 * VS + s * 32);
                o0 = MFMA32(v0, pf, o0); o1 = MFMA32(v1, pf, o1);
            }
        }
        if (i + 1 < ntiles) lstore(buf ^ 1);
        __syncthreads();
    }
    lrun += __shfl_xor(lrun, 32);
    const bool valid = meta ? (w == 0 && ql < 16) : true;
    store_o(o0, o1, 1.0f / lrun, O + (size_t)qrow * 1024 + 512 + h * 64, ss + qrow, hi, valid);
}

__device__ __forceinline__ void sb_unit(int wave_s, LAS unsigned char* lds, const bf16_t* QK, const bf16_t* VT, bf16_t* O, float* ss, int b, int h, int qb) {
    int tid_ = phase_tid(wave_s);
    const int tid = tid_, lane = tid & 63, w = __builtin_amdgcn_readfirstlane(tid >> 6), ql = lane & 31, hi = lane >> 5;
    const bool meta = qb < 0;
    const int qrow = meta ? (TREAL + b * 16 + (ql & 15)) : (b * SEQ + qb * 256 + w * 32 + ql);
    const int qt = meta ? ql : (qb * 256 + w * 32 + ql);
    bf16x8 qf[4];
#pragma unroll
    for (int ks = 0; ks < 4; ++ks) qf[ks] = *(const bf16x8*)(QK + (size_t)qrow * 1024 + h * 64 + (2 * ks + hi) * 8);
    const int ntiles = meta ? 1 : 4 * qb + 5;
    const int wfirst = meta ? (w == 0 ? 0 : 1) : 3 - (w >> 1);
    const int krow = tid >> 3, kch = tid & 7;
    const unsigned aoff = (unsigned)(pi_row(ql) * KS_SB + hi * 16), voff = (unsigned)(ql * VS + hi * 16);
    f32x16 o0, o1;
#pragma unroll
    for (int i = 0; i < 16; ++i) { o0[i] = 0.f; o1[i] = 0.f; }
    float carry = 0.f;
    u32x4 rk, rv;
    auto gload = [&](int i) {
        const int row0 = (meta || i == ntiles - 1) ? TREAL + b * 16 : b * SEQ + 64 * (4 * qb + 3 - i);
        rk = *(const u32x4*)(QK + (size_t)(row0 + krow) * 1024 + 512 + h * 64 + kch * 8);
        rv = *(const u32x4*)(VT + (size_t)(h * 64 + krow) * MP + row0 + kch * 8);
    };
    auto lstore = [&](int buf) {
        *(LAS u32x4*)(lds + KB0 + buf * KBSZ + krow * KS_SB + kch * 16) = rk;
        *(LAS u32x4*)(lds + VB0 + buf * VBSZ + krow * VS + kch * 16) = rv;
    };
    LAS int* flg = (LAS int*)(lds + FLG);
    gload(0); lstore(0); __syncthreads();
    for (int i = 0; i < ntiles; ++i) {
        const int buf = i & 1;
        if (i > 0) {
            int all = 1;
#pragma unroll
            for (int k = 0; k < NWAVE; ++k) all &= flg[(buf ^ 1) * NWAVE + k];
#ifndef NO_EXIT
            if (all) break;
#endif
        }
        if (i + 1 < ntiles) gload(i + 1);
        if (i >= wfirst) {
            const LAS unsigned char* kb = lds + KB0 + buf * KBSZ + aoff; const LAS unsigned char* vb = lds + VB0 + buf * VBSZ + voff;
            f32x16 s0, s1, l0, l1;
#pragma unroll
            for (int r = 0; r < 16; ++r) { s0[r] = 0.f; s1[r] = 0.f; }
#pragma unroll
            for (int ks = 0; ks < 4; ++ks) {
                const bf16x8 a0 = *(const LAS bf16x8*)(kb + ks * 32), a1 = *(const LAS bf16x8*)(kb + 32 * KS_SB + ks * 32);
                s0 = MFMA32(a0, qf[ks], s0); s1 = MFMA32(a1, qf[ks], s1);
            }
            const bool mtile = meta || i == ntiles - 1;
            const int lim = mtile ? (meta ? (ql < 16 ? ql - 1 : 15) : 15) : qt - 64 * (4 * qb + 3 - i) - 1;
#pragma unroll
            for (int r = 0; r < 16; ++r) {
                const int ki = 16 * (r >> 3) + 8 * hi + (r & 7);
                { const float z = s0[r], sp = fmaxf(z, 0.f) + 0.69314718056f * __builtin_amdgcn_logf(1.f + __builtin_amdgcn_exp2f(-1.44269504089f * fabsf(z))); const bool ok = ki <= lim; l0[r] = ok ? -sp : 0.f; s0[r] = ok ? z : -INFINITY; }
                { const float z = s1[r], sp = fmaxf(z, 0.f) + 0.69314718056f * __builtin_amdgcn_logf(1.f + __builtin_amdgcn_exp2f(-1.44269504089f * fabsf(z))); const bool ok = ki + 32 <= lim; l1[r] = ok ? -sp : 0.f; s1[r] = ok ? z : -INFINITY; }
            }
            float og[4], pg[4];
#pragma unroll
            for (int q = 0; q < 4; ++q) { const f32x16& l = (q >> 1) ? l1 : l0; const int o = 8 * (q & 1);
                og[q] = ((l[o] + l[o + 1]) + (l[o + 2] + l[o + 3])) + ((l[o + 4] + l[o + 5]) + (l[o + 6] + l[o + 7])); pg[q] = __shfl_xor(og[q], 32); }
            float tail = carry;
#pragma unroll
            for (int q = 3; q >= 0; --q) {
                f32x16& l = (q >> 1) ? l1 : l0; f32x16& s = (q >> 1) ? s1 : s0; const int o = 8 * (q & 1);
                float run = tail + (hi == 0 ? pg[q] : 0.f);
#pragma unroll
                for (int j = 7; j >= 0; --j) { const float lm = l[o + j]; s[o + j] = __builtin_amdgcn_exp2f(1.44269504089f * (s[o + j] + lm + run)); run += lm; }
                tail += og[q] + pg[q];
            }
            carry = tail;
#pragma unroll
            for (int s = 0; s < 4; ++s) {
                const bf16x8 pf = pack8((s >> 1) ? s1 : s0, 8 * (s & 1));
                const bf16x8 v0 = *(const LAS bf16x8*)(vb + s * 32), v1 = *(const LAS bf16x8*)(vb + 32 * VS + s * 32);
                o0 = MFMA32(v0, pf, o0); o1 = MFMA32(v1, pf, o1);
            }
        }
        { const int dn = (__ballot(carry >= -104.0f) == 0ull) ? 1 : 0; if (lane == 0) flg[buf * NWAVE + w] = dn; }
        if (i + 1 < ntiles) lstore(buf ^ 1);
        __syncthreads();
    }
    __syncthreads();
    const bool valid = meta ? (w == 0 && ql < 16) : true;
    store_o(o0, o1, 1.0f, O + (size_t)qrow * 1024 + h * 64, ss + qrow, hi, valid);
}

__device__ __forceinline__ void phase_attention(const Params& p, LAS unsigned char* lds, int layer, int wave_s) {
    unsigned char* g = p.ws + WS_G;
    const bf16_t* QK = (const bf16_t*)(g + G_QK); const bf16_t* VTS = (const bf16_t*)(g + G_VTS);
    const bf16_t* QM = (const bf16_t*)(g + G_QM); const bf16_t* KN = (const bf16_t*)(g + G_KN); const bf16_t* KR = (const bf16_t*)(g + G_KR); const bf16_t* VTM = (const bf16_t*)(g + G_VTM);
    bf16_t* O = (bf16_t*)(g + G_O);
    float* ss_sb = (float*)(p.ws + WS_SS) + (size_t)(layer * 4 + 2) * MP; float* ss_ml = ss_sb + MP;
    const int nunits = layer == 1 ? 2048 : 2176;
    for (int idx = blockIdx.x; idx < nunits; idx += gridDim.x) {
        if (idx < 1024) {
            const int rnd = idx >> 8, cc = idx & 255, grp = cc >> 6, bh = cc & 63;
            const int qb = rnd == 0 ? 15 - grp : rnd == 1 ? 8 + grp : rnd == 2 ? 7 - grp : grp;
            mla_unit(wave_s, lds, QM, KN, KR, VTM, O, ss_ml, bh >> 3, bh & 7, qb);
        } else if (idx < 2048) {
            const int k = idx - 1024, bh = k & 63, qb = k >> 6;
            sb_unit(wave_s, lds, QK, VTS, O, ss_sb, bh >> 3, bh & 7, qb);
        } else if (idx < 2112) { const int bh = idx - 2048; mla_unit(wave_s, lds, QM, KN, KR, VTM, O, ss_ml, bh >> 3, bh & 7, -1); }
        else { const int bh = idx - 2112; sb_unit(wave_s, lds, QK, VTS, O, ss_sb, bh >> 3, bh & 7, -1); }
    }
}
}

__global__ void __launch_bounds__(NTHR) hybrid_fwd(Params p) {
    extern __shared__ __attribute__((aligned(16))) unsigned char smem[];
    LAS unsigned char* lds = (LAS unsigned char*)smem;
    cg::grid_group grid = cg::this_grid();
    const int wave_s = __builtin_amdgcn_readfirstlane((int)threadIdx.x >> 6);
    unsigned char* ws = p.ws; unsigned char* g = ws + WS_G;
    const float* cosT = (const float*)(ws + WS_ROPE); const float* sinT = cosT + LPOS * 16;
    bf16_t* xn = (bf16_t*)(ws + WS_XN);
    const int lo = p.ph_lo, hi = p.ph_hi;
    int ph = 0;
#ifndef PHMASK
#define PHMASK 0xFFFFFFFFu
#endif
#define PHASE_BEGIN if (ph >= lo && ph < hi) {
#define PHASE_END   if (ph + 1 < hi) grid.sync(); } ++ph;

    PHASE_BEGIN if (PHMASK & 1u) phase_prologue(p, lds, wave_s); PHASE_END
    for (int layer = 0; layer < 2; ++layer) {
        unsigned char* wl = ws + WS_W + (size_t)layer * W_LAYER;
        float* ssb = (float*)(ws + WS_SS) + (size_t)layer * 4 * MP;
        float *ss_cq = ssb, *ss_ckv = ssb + MP, *ss_osb = ssb + 2 * MP, *ss_oml = ssb + 3 * MP;
        const int Mrows = layer == 1 ? TREAL : MP, nrows = layer == 1 ? TREAL : TTOT;
        PHASE_BEGIN if (PHMASK & 2u) {
            epi::Main E{(bf16_t*)(g + G_QK), (bf16_t*)(g + G_CQ), (bf16_t*)(g + G_CKV), (bf16_t*)(g + G_KR), ss_cq, ss_ckv, cosT, sinT};
#ifndef NO_A
            run_gemm(lds, xn, 1024, (const bf16_t*)(wl + W_MAIN), 1024, MP, NMAIN, 1024, -1, 0, E, wave_s);
#endif
            epi::Bf16R EV{(bf16_t*)(g + G_VTS), MP, nullptr, 0.f};
#ifndef NO_B
            run_gemm(lds, (const bf16_t*)(wl + W_V), 1024, xn, 1024, 512, MP, 1024, -1, 136, EV, wave_s);
#endif
 }
        PHASE_END
        PHASE_BEGIN if (PHMASK & 4u) {
            epi::QMla EQ{(bf16_t*)(g + G_QM), ss_cq, cosT, sinT};
#ifndef NO_A
            run_gemm(lds, (const bf16_t*)(g + G_CQ), 384, (const bf16_t*)(wl + W_UQ), 384, MP, 768, 384, -1, 0, EQ, wave_s);
#endif
            epi::Bf16R EK{(bf16_t*)(g + G_KN), 512, ss_ckv, 1.f / KVLORA};
#ifndef NO_B
            run_gemm(lds, (const bf16_t*)(g + G_CKV), 256, (const bf16_t*)(wl + W_UK), 256, MP, 512, 256, -1, 128, EK, wave_s);
#endif
            epi::Bf16C EV{(bf16_t*)(g + G_VTM), MP, ss_ckv, 1.f / KVLORA};
#ifndef NO_C
            run_gemm(lds, (const bf16_t*)(wl + W_UV), 256, (const bf16_t*)(g + G_CKV), 256, 512, MP, 256, -1, 136, EV, wave_s);
#endif
 }
        PHASE_END
        PHASE_BEGIN if (PHMASK & 8u) att::phase_attention(p, lds, layer, wave_s); PHASE_END
        PHASE_BEGIN if (PHMASK & 16u) {
            epi::Wo E{(float*)(g + G_MIX), ss_osb, ss_oml};
            run_gemm(lds, (const bf16_t*)(g + G_O), 1024, (const bf16_t*)(wl + W_O), 1024, Mrows, 1024, 1024, 8, 0, E, wave_s); }
        PHASE_END
        PHASE_BEGIN if (PHMASK & 32u) phase_rows(p, (const float*)(g + G_MIX), p.in[11] + layer * DM, p.in[12] + layer * DM, true, nrows, wave_s); PHASE_END
        PHASE_BEGIN if (PHMASK & 64u) {
            epi::GateUp E{(bf16_t*)(g + G_ACT)};
            run_gemm(lds, xn, 1024, (const bf16_t*)(wl + W_GU), 1024, Mrows, NGU, 1024, -1, 0, E, wave_s); }
        PHASE_END
        PHASE_BEGIN if (PHMASK & 128u) {
            epi::F32Out E{(float*)(g + G_FFN)};
            run_gemm(lds, (const bf16_t*)(g + G_ACT), DFF, (const bf16_t*)(wl + W_D), DFF, Mrows, 1024, DFF, -1, 0, E, wave_s); }
        PHASE_END
        PHASE_BEGIN if (PHMASK & 256u) phase_rows(p, (const float*)(g + G_FFN), p.in[13] + layer * DM, p.in[10] + (layer < 1 ? (layer + 1) * DM : 0), layer < 1, nrows, wave_s); PHASE_END
    }
}
constexpr int N_PHASES = 17;

#ifdef DBG_STOP
__global__ void __launch_bounds__(256) dbg_dump(Params p) {
    unsigned char* g = p.ws + WS_G;
    const size_t n = (size_t)TREAL * DM;
    for (size_t i = (size_t)blockIdx.x * 256 + threadIdx.x; i < n; i += (size_t)gridDim.x * 256) {
        const size_t row = i >> 10, c = i & 1023; float v = 0.f;
        auto bf = [](const unsigned char* b, size_t idx) { return __uint_as_float((unsigned)((const bf16_t*)b)[idx] << 16); };
#if DBG_DUMP == 1
        v = bf(g + G_QK, row * 1024 + c) + bf(g + G_CQ, row * 384 + c % 384) + bf(g + G_CKV, row * 256 + c % 256) + bf(g + G_KR, row * 32 + c % 32) + bf(g + G_VTS, (c % 512) * MP + row)
          + ((const float*)(p.ws + WS_SS))[row] + ((const float*)(p.ws + WS_SS))[MP + row];
#elif DBG_DUMP == 2
        v = bf(g + G_QM, row * 768 + c % 768) + bf(g + G_KN, row * 512 + c % 512) + bf(g + G_VTM, (c % 512) * MP + row);
#elif DBG_DUMP == 3
        v = bf(g + G_O, row * 1024 + c);
#elif DBG_DUMP == 31
        v = c < 512 ? bf(g + G_O, row * 1024 + c) : 0.f;
#elif DBG_DUMP == 32
        v = c >= 512 ? bf(g + G_O, row * 1024 + c) : 0.f;
#elif DBG_DUMP == 4
        v = ((const float*)(g + G_MIX))[row * 1024 + c];
#elif DBG_DUMP == 5
        v = bf(p.ws + WS_XN, row * 1024 + c);
#elif DBG_DUMP == 6
        v = bf(g + G_ACT, row * DFF + c) + bf(g + G_ACT, row * DFF + 1024 + c) + bf(g + G_ACT, row * DFF + 1792 + c);
#elif DBG_DUMP == 7
        v = ((const float*)(g + G_FFN))[row * 1024 + c];
#endif
#ifdef DBG_SAN
        if (!(fabsf(v) < 1e30f)) v = 12345.f;
#endif
        p.out[i] = v;
    }
}
#endif

extern "C" void kernel_launch(void* const* d_in, const int* in_sizes, int n_in, void* d_out, int out_size, void* d_ws, size_t ws_size, hipStream_t stream) {
    static int grid = 0;
    if (grid == 0) {
        if (n_in != 17 || ws_size < WS_END) { fprintf(stderr, "kernel_launch: need 17 inputs and %zu bytes of workspace (got %d, %zu)\n", (size_t)WS_END, n_in, ws_size); grid = -1; return; }
        int dev = 0, cus = 0, per_cu = 0;
        (void)hipGetDevice(&dev); (void)hipDeviceGetAttribute(&cus, hipDeviceAttributeMultiprocessorCount, dev);
        (void)hipFuncSetAttribute((const void*)hybrid_fwd, hipFuncAttributeMaxDynamicSharedMemorySize, LDS_BYTES);
        (void)hipOccupancyMaxActiveBlocksPerMultiprocessor(&per_cu, (const void*)hybrid_fwd, NTHR, LDS_BYTES);
        if (per_cu < 1) { fprintf(stderr, "kernel_launch: occupancy query says %d blocks per CU\n", per_cu); per_cu = 1; }
        (void)hipGetLastError();
        grid = cus * 1;
    }
    if (grid < 0) return;
    Params p; memset(&p, 0, sizeof(p));
    for (int i = 0; i < 17; ++i) p.in[i] = (const float*)d_in[i];
    p.out = (float*)d_out; p.ws = (unsigned char*)d_ws;
    for (int i = 0; i < 16; ++i) p.inv_freq[i] = 1.0f / powf(10000.0f, (float)(2 * i) / 32.0f);
#ifndef MK_LAUNCHES
#define MK_LAUNCHES 1
#endif
    if (MK_LAUNCHES == 1) {
        p.ph_lo = 0; p.ph_hi = N_PHASES;
        void* args[] = {&p};
        hipError_t e = hipLaunchCooperativeKernel((const void*)hybrid_fwd, dim3(grid), dim3(NTHR), args, LDS_BYTES, stream);
        if (e != hipSuccess) fprintf(stderr, "cooperative launch failed: %s (grid %d)\n", hipGetErrorString(e), grid);
    } else {
#ifdef DBG_STOP
        for (int k = 0; k < DBG_STOP; ++k) { p.ph_lo = k; p.ph_hi = k + 1; hipLaunchKernelGGL(hybrid_fwd, dim3(grid), dim3(NTHR), LDS_BYTES, stream, p); }
        hipLaunchKernelGGL(dbg_dump, dim3(2048), dim3(256), 0, stream, p);
#else
        for (int k = 0; k < N_PHASES; ++k) { p.ph_lo = k; p.ph_hi = k + 1; hipLaunchKernelGGL(hybrid_fwd, dim3(grid), dim3(NTHR), LDS_BYTES, stream, p); }
#endif
    }
}
```

```cpp
#include <hip/hip_runtime.h>
#include <hip/hip_cooperative_groups.h>
#include <cstdio>
#include <cstdint>
#include <cmath>
#include <cstring>
namespace cg = cooperative_groups;

__device__ __forceinline__ int phase_tid(int wave_s) { int lane; asm volatile("v_mbcnt_lo_u32_b32 %0, -1, 0\n\tv_mbcnt_hi_u32_b32 %0, -1, %0" : "=v"(lane)); return wave_s * 64 + lane; }

namespace pg8 {
#define PG8_LAS __attribute__((address_space(3)))
typedef unsigned short bf16_t;
typedef short bf16x8 __attribute__((ext_vector_type(8)));
typedef float f32x4 __attribute__((ext_vector_type(4)));
typedef unsigned u32x4 __attribute__((ext_vector_type(4)));
constexpr int BM = 256, BK = 64, HALF = 128, HTB = HALF * BK * 2  , STAGE_BYTES = 8 * HTB, NXCD = 8, WGM = 8;

__host__ __device__ __forceinline__ int lds_byte(int r, int c) { const int st = (r >> 4) * 2 + (c >> 5), rr = r & 15, cc = c & 31, ob = rr * 64 + cc * 2; return st * 1024 + (ob ^ (((ob >> 9) & 1) << 5)); }
__host__ __device__ __forceinline__ void stage_rc(int b, int& R, int& C) { const int st = b / 1024, sb = b % 1024, swz = sb ^ (((sb >> 9) & 1) << 5); R = (st >> 1) * 16 + swz / 64; C = (st & 1) * 32 + (swz % 64) / 2; }
__host__ __device__ __forceinline__ int perm32(int rho) { const int n = rho >> 4, i = rho & 15; return 8 * (i >> 2) + 4 * n + (i & 3); }

struct Unit { int pm, pn; };
struct Gemm { const bf16_t* A; const bf16_t* Bt; int M, N, K, lda, ldb, kmid; };

struct StaticOrder {
    int nM, nN, nwg, G, c;
    __host__ __device__ void init(int M, int N, int G_, int c_) { nM = M / BM; nN = N / BM; nwg = nM * nN; G = G_; c = c_; }
    __host__ __device__ bool next(int i, Unit& u) const {
        const long L = (long)i * G + c; if (L >= nwg) return false;
        int wgid = (int)L; { const int q = nwg / NXCD, r = nwg % NXCD, xcd = wgid % NXCD, off = wgid / NXCD; wgid = (xcd < r ? xcd * (q + 1) : r * (q + 1) + (xcd - r) * q) + off; }
        const int nig = WGM * nN, gid = wgid / nig, fm = gid * WGM, gsz = (nM - fm) < WGM ? (nM - fm) : WGM;
        u.pm = fm + ((wgid % nig) % gsz); u.pn = (wgid % nig) / gsz; return true;
    }
    __device__ __forceinline__ void a_ready(const Unit&) const {}
    __device__ __forceinline__ void done(const Unit&) const {}
};


template <class Epi, class Sched, bool ALIGN_EPI = false, bool SP2 = false>
__device__ __forceinline__ void gemm_phase(PG8_LAS unsigned char* lds, const Gemm g, const Sched& S, const Epi& E, const int wave_s) {
    int tid_ = phase_tid(wave_s);
    const int tid = tid_, wid = __builtin_amdgcn_readfirstlane(tid >> 6), lane = tid & 63, wr = wid >> 2, wc = wid & 3, fr = lane & 15, fq = lane >> 4;
    const int K = g.K, nt = K / BK;
    unsigned voffA[2], voffB[2];
#pragma unroll
    for (int i = 0; i < 2; ++i) { int R, C; stage_rc(tid * 16 + i * 8192, R, C); const int Rb = Epi::PERM ? ((R & ~31) + perm32(R & 31)) : R;
        voffA[i] = (unsigned)(R * g.lda + C) * 2u; voffB[i] = (unsigned)(Rb * g.ldb + C) * 2u; }
    const size_t kstep = (size_t)(BK * 2);
    const size_t hstepA = (size_t)HALF * g.lda * 2, hstepB = (size_t)HALF * g.ldb * 2;
    const size_t tstepA = 2 * hstepA, tstepB = 2 * hstepB;
    const unsigned ldsw = (unsigned)wid * 1024u;
    const int aoff = lds_byte(wr * 64 + fr, fq * 8), boff = lds_byte(wc * 32 + fr, fq * 8);
#define PG8_SA(b, h) (((b) * 2 + (h)) * HTB)
#define PG8_SB(b, h) ((4 + (b) * 2 + (h)) * HTB)
#define PG8_STAGE(bufoff, gbase, voff) do { _Pragma("unroll") for (int _i = 0; _i < 2; ++_i) \
        __builtin_amdgcn_global_load_lds((const unsigned*)((const char*)(gbase) + (voff)[_i]), (PG8_LAS unsigned*)(lds + (bufoff) + ldsw + _i * 8192), 16, 0, 0); } while (0)
#define PG8_LDA(dst, b, h) do { _Pragma("unroll") for (int m = 0; m < 4; ++m) _Pragma("unroll") for (int k = 0; k < 2; ++k) dst[m][k] = *(const PG8_LAS bf16x8*)(lds + PG8_SA(b, h) + aoff + m * 2048 + k * 1024); } while (0)
#define PG8_LDB(dst, b, h) do { _Pragma("unroll") for (int n = 0; n < 2; ++n) _Pragma("unroll") for (int k = 0; k < 2; ++k) dst[n][k] = *(const PG8_LAS bf16x8*)(lds + PG8_SB(b, h) + boff + n * 2048 + k * 1024); } while (0)
#define PG8_MMA(ai, bj, At, Bt) do { __builtin_amdgcn_s_setprio(1); _Pragma("unroll") for (int m = 0; m < 4; ++m) _Pragma("unroll") for (int n = 0; n < 2; ++n) _Pragma("unroll") for (int k = 0; k < 2; ++k) \
        acc[ai][bj][m][n] = __builtin_amdgcn_mfma_f32_16x16x32_bf16(Bt[n][k], At[m][k], acc[ai][bj][m][n], 0, 0, 0); __builtin_amdgcn_s_setprio(0); } while (0)
#define PG8_WAIT_V(n) asm volatile("s_waitcnt vmcnt(" #n ")" ::: "memory")
#define PG8_WAIT_L(n) asm volatile("s_waitcnt lgkmcnt(" #n ")" ::: "memory")
#define PG8_BAR __builtin_amdgcn_s_barrier()
#define PG8_SCHED __builtin_amdgcn_sched_barrier(0)
    Unit cur, nxt; int ui = 0;
    if (!S.next(0, cur)) return;
    f32x4 acc[2][2][4][2];
#pragma unroll
    for (int a = 0; a < 2; ++a)
#pragma unroll
        for (int b = 0; b < 2; ++b)
#pragma unroll
            for (int m = 0; m < 4; ++m)
#pragma unroll
                for (int n = 0; n < 2; ++n) acc[a][b][m][n] = (f32x4){0.f, 0.f, 0.f, 0.f};
    bf16x8 At[4][2], B0[2][2], B1[2][2];
    const char* cA = (const char*)g.A + (size_t)cur.pm * tstepA; const char* cB = (const char*)g.Bt + (size_t)cur.pn * tstepB;
    S.a_ready(cur);
    if constexpr (SP2) {
        PG8_STAGE(PG8_SB(0, 0), cB, voffB); PG8_STAGE(PG8_SB(0, 1), cB + hstepB, voffB); PG8_STAGE(PG8_SA(0, 0), cA, voffA); PG8_STAGE(PG8_SA(0, 1), cA + hstepA, voffA);
        if (wr == 1) PG8_BAR;
        PG8_WAIT_V(2); PG8_BAR;
        PG8_STAGE(PG8_SB(1, 0), cB + kstep, voffB); PG8_STAGE(PG8_SA(1, 0), cA + kstep, voffA); PG8_STAGE(PG8_SB(1, 1), cB + hstepB + kstep, voffB);
        PG8_WAIT_V(6); PG8_BAR;
    } else {
        PG8_STAGE(PG8_SB(0, 0), cB, voffB); PG8_STAGE(PG8_SA(0, 0), cA, voffA); PG8_STAGE(PG8_SB(0, 1), cB + hstepB, voffB); PG8_STAGE(PG8_SA(0, 1), cA + hstepA, voffA);
        if (wr == 1) PG8_BAR;
        PG8_WAIT_V(4); PG8_BAR;
        PG8_STAGE(PG8_SB(1, 0), cB + kstep, voffB); PG8_STAGE(PG8_SA(1, 0), cA + kstep, voffA); PG8_STAGE(PG8_SB(1, 1), cB + hstepB + kstep, voffB);
        PG8_WAIT_V(6); PG8_BAR;
    }
    for (;;) {
        const bool has_next = S.next(ui + 1, nxt);
        const char* nA = has_next ? (const char*)g.A + (size_t)nxt.pm * tstepA : cA; const char* nB = has_next ? (const char*)g.Bt + (size_t)nxt.pn * tstepB : cB;
        for (int t = 0; t < nt; t += 2) {
            const bool last = (t == nt - 2);
            if constexpr (Epi::HAS_MID) { if (t == g.kmid) { const int lane_e = phase_tid(0), fr_e = lane_e & 15, fq_e = lane_e >> 4; E.mid(acc, cur, wr, wc, fr_e, fq_e); } }
            const char* a1 = cA + (size_t)(t + 1) * kstep;
            const char* a2 = last ? nA : cA + (size_t)(t + 2) * kstep; const char* b2 = last ? nB : cB + (size_t)(t + 2) * kstep;
            const char* a3 = a2 + kstep; const char* b3 = b2 + kstep;
            if (last && has_next) S.a_ready(nxt);
            if constexpr (SP2) {
            PG8_LDB(B0, 0, 0); PG8_LDB(B1, 0, 1); PG8_SCHED; PG8_LDA(At, 0, 0); PG8_STAGE(PG8_SA(1, 1), a1 + hstepA, voffA);
            PG8_WAIT_V(8); PG8_WAIT_L(0); PG8_BAR; PG8_MMA(0, 0, At, B0); PG8_MMA(0, 1, At, B1); PG8_BAR; PG8_SCHED;
            PG8_LDA(At, 0, 1); PG8_STAGE(PG8_SB(0, 0), b2, voffB); PG8_STAGE(PG8_SB(0, 1), b2 + hstepB, voffB); PG8_STAGE(PG8_SA(0, 0), a2, voffA);
            PG8_WAIT_V(8); PG8_WAIT_L(0); PG8_BAR; PG8_MMA(1, 0, At, B0); PG8_MMA(1, 1, At, B1); PG8_BAR; PG8_SCHED;
            PG8_LDB(B0, 1, 0); PG8_LDB(B1, 1, 1); PG8_SCHED; PG8_LDA(At, 1, 0); PG8_STAGE(PG8_SA(0, 1), a2 + hstepA, voffA);
            PG8_WAIT_V(8); PG8_WAIT_L(0); PG8_BAR; PG8_MMA(0, 0, At, B0); PG8_MMA(0, 1, At, B1); PG8_BAR; PG8_SCHED;
            PG8_LDA(At, 1, 1); PG8_STAGE(PG8_SB(1, 0), b3, voffB); PG8_STAGE(PG8_SB(1, 1), b3 + hstepB, voffB); PG8_STAGE(PG8_SA(1, 0), a3, voffA);
            PG8_WAIT_V(8); PG8_WAIT_L(0); PG8_BAR; PG8_MMA(1, 0, At, B0); PG8_MMA(1, 1, At, B1); PG8_BAR; PG8_SCHED;
            } else {
            PG8_LDB(B0, 0, 0); PG8_SCHED; PG8_LDA(At, 0, 0); PG8_STAGE(PG8_SA(1, 1), a1 + hstepA, voffA);
            PG8_WAIT_L(8); PG8_BAR; PG8_WAIT_L(0); PG8_MMA(0, 0, At, B0); PG8_BAR; PG8_SCHED;
            PG8_LDB(B1, 0, 1); PG8_STAGE(PG8_SB(0, 0), b2, voffB);
            PG8_BAR; PG8_WAIT_L(0); PG8_MMA(0, 1, At, B1); PG8_BAR;
            PG8_LDA(At, 0, 1); PG8_STAGE(PG8_SA(0, 0), a2, voffA);
            PG8_BAR; PG8_WAIT_L(0); PG8_MMA(1, 0, At, B0); PG8_BAR; PG8_SCHED;
            PG8_STAGE(PG8_SB(0, 1), b2 + hstepB, voffB);
            PG8_WAIT_V(6); PG8_BAR; PG8_MMA(1, 1, At, B1); PG8_BAR;
            PG8_LDB(B0, 1, 0); PG8_SCHED; PG8_LDA(At, 1, 0); PG8_STAGE(PG8_SA(0, 1), a2 + hstepA, voffA);
            PG8_WAIT_L(8); PG8_BAR; PG8_WAIT_L(0); PG8_MMA(0, 0, At, B0); PG8_BAR; PG8_SCHED;
            PG8_LDB(B1, 1, 1); PG8_STAGE(PG8_SB(1, 0), b3, voffB);
            PG8_BAR; PG8_WAIT_L(0); PG8_MMA(0, 1, At, B1); PG8_BAR;
            PG8_LDA(At, 1, 1); PG8_STAGE(PG8_SA(1, 0), a3, voffA);
            PG8_BAR; PG8_WAIT_L(0); PG8_MMA(1, 0, At, B0); PG8_BAR; PG8_SCHED;
            PG8_STAGE(PG8_SB(1, 1), b3 + hstepB, voffB);
            PG8_WAIT_V(6); PG8_BAR; PG8_MMA(1, 1, At, B1); PG8_BAR;
            }
        }
        if constexpr (ALIGN_EPI) { if (wr == 0) PG8_BAR; }
        if constexpr (!Epi::AFTER_DRAIN) { const int lane_e = phase_tid(0), fr_e = lane_e & 15, fq_e = lane_e >> 4;
            E(acc, cur, wr, wc, fr_e, fq_e); S.done(cur); }
        if (!has_next) break;
#pragma unroll
        for (int a = 0; a < 2; ++a)
#pragma unroll
            for (int b = 0; b < 2; ++b)
#pragma unroll
                for (int m = 0; m < 4; ++m)
#pragma unroll
                    for (int n = 0; n < 2; ++n) acc[a][b][m][n] = (f32x4){0.f, 0.f, 0.f, 0.f};
        cur = nxt; cA = nA; cB = nB; ++ui;
        if constexpr (ALIGN_EPI) { if (wr == 1) PG8_BAR; }
    }
    PG8_WAIT_V(0);
    if constexpr (!ALIGN_EPI) { if (wr == 0) PG8_BAR; }
    PG8_BAR;
    if constexpr (Epi::AFTER_DRAIN) { E.fused(acc, cur, wr, wc, fr, fq, lds, wid, lane); S.done(cur); }
#undef PG8_SA
#undef PG8_SB
#undef PG8_STAGE
#undef PG8_LDA
#undef PG8_LDB
#undef PG8_MMA
#undef PG8_WAIT_V
#undef PG8_WAIT_L
#undef PG8_BAR
#undef PG8_SCHED
}
}


#define LAS __attribute__((address_space(3)))
typedef unsigned short bf16_t;
typedef short bf16x8 __attribute__((ext_vector_type(8)));
typedef float f32x4 __attribute__((ext_vector_type(4)));
typedef float f32x16 __attribute__((ext_vector_type(16)));
typedef unsigned u32x4 __attribute__((ext_vector_type(4)));
typedef unsigned u32x2 __attribute__((ext_vector_type(2)));

constexpr int NB = 8, SEQ = 4096, NMETA = 16, DM = 1024, TREAL = NB * SEQ, TTOT = TREAL + NB * NMETA, MP = 33024, LPOS = SEQ + NMETA;
constexpr int NMAIN = 1792, DFF = 2816, NGU = 2 * DFF, QLORA = 384, KVLORA = 256;
constexpr float EPS = 1e-6f;
constexpr int NTHR = 512, NWAVE = 8;
constexpr int LDS_BYTES = 131072;

constexpr size_t al256(size_t x) { return (x + 255) & ~(size_t)255; }
constexpr size_t WS_ROPE = 0;
constexpr size_t ROPE_BYTES = al256(2ull * LPOS * 16 * 4);
constexpr size_t WS_SS = WS_ROPE + ROPE_BYTES;
constexpr size_t SS_FLOATS = 2ull * 4 * MP;
constexpr size_t WS_HMETA = WS_SS + al256(SS_FLOATS * 4);
constexpr size_t WS_W = WS_HMETA + 256ull * 1024 * 4;
constexpr size_t W_MAIN = 0, W_V = W_MAIN + 1792ull * 1024 * 2, W_UQ = W_V + 512ull * 1024 * 2, W_UK = W_UQ + 768ull * 384 * 2, W_UV = W_UK + 512ull * 256 * 2,
                 W_O = W_UV + 512ull * 256 * 2, W_GU = W_O + 1024ull * 1024 * 2, W_D = W_GU + 5632ull * 1024 * 2, W_LAYER = W_D + 1024ull * 2816 * 2;
constexpr size_t WS_XN = WS_W + 2 * W_LAYER;
constexpr size_t WS_G = WS_XN + (size_t)MP * 1024 * 2;
constexpr size_t G_QK = 0, G_CQ = G_QK + (size_t)MP * 1024 * 2, G_CKV = G_CQ + (size_t)MP * 384 * 2, G_KR = G_CKV + (size_t)MP * 256 * 2, G_VTS = G_KR + (size_t)MP * 32 * 2,
                 G_QM = G_VTS + 512ull * MP * 2, G_KN = G_QM + (size_t)MP * 768 * 2, G_VTM = G_KN + (size_t)MP * 512 * 2, G_O = G_VTM + 512ull * MP * 2, G_END = G_O + (size_t)MP * 1024 * 2;
constexpr size_t G_MIX = 0, G_ACT = 0, G_FFN = G_ACT + (size_t)MP * DFF * 2;
static_assert(G_MIX + (size_t)MP * 1024 * 4 <= G_QM, "mix overlays only dead buffers");
static_assert(G_FFN + (size_t)MP * 1024 * 4 <= G_END, "ffn inside group");
constexpr size_t WS_END = WS_G + G_END;

struct Params {
    const float* in[17];
    float* out; unsigned char* ws;
    float inv_freq[16];
    int ph_lo, ph_hi;
};

typedef __bf16 bf16x2_t __attribute__((ext_vector_type(2)));
typedef float f32x2_t __attribute__((ext_vector_type(2)));
__device__ __forceinline__ unsigned pk_bf16(float lo, float hi) { const f32x2_t v = {lo, hi}; const bf16x2_t b = __builtin_convertvector(v, bf16x2_t); return __builtin_bit_cast(unsigned, b); }
__device__ __forceinline__ float wave_sum(float v) {
#pragma unroll
    for (int o = 1; o < 64; o <<= 1) v += __shfl_xor(v, o);
    return v;
}
__device__ __forceinline__ int row_pos(int row) { return row < TREAL ? NMETA + (row & (SEQ - 1)) : ((row - TREAL) & (NMETA - 1)); }

namespace epi {
using pg8::Unit;
typedef const f32x4 (&AccC)[2][2][4][2];
typedef f32x4 (&AccM)[2][2][4][2];

struct Main {
    static constexpr bool PERM = false, AFTER_DRAIN = false, HAS_MID = false;
    bf16_t *qk, *cq, *ckv, *kr; float *ss_cq, *ss_ckv; const float *cosT, *sinT;
    template <int BJ, int MODE, bool SS>
    __device__ __forceinline__ void half(AccC acc, bf16_t* dst, int ldc, int c0, float* ss, int rbase, int fq) const {
#pragma unroll
        for (int ai = 0; ai < 2; ++ai)
#pragma unroll
            for (int m = 0; m < 4; ++m) {
                const int row = rbase + ai * 128 + m * 16;
                f32x4 v0 = acc[ai][BJ][m][0], v1 = acc[ai][BJ][m][1];
                if (MODE == 1) {
                    const int pos = row_pos(row);
                    const f32x4 c = *(const f32x4*)(cosT + pos * 16 + 4 * fq), s = *(const f32x4*)(sinT + pos * 16 + 4 * fq);
                    const f32x4 a = v0 * c - v1 * s, b = v1 * c + v0 * s; v0 = a; v1 = b;
                }
                bf16_t* p = dst + (size_t)row * ldc + c0;
                *(u32x2*)p = (u32x2){pk_bf16(v0[0], v0[1]), pk_bf16(v0[2], v0[3])};
                *(u32x2*)(p + 16) = (u32x2){pk_bf16(v1[0], v1[1]), pk_bf16(v1[2], v1[3])};
                if (SS) {
                    float s = (v0[0] * v0[0] + v0[1] * v0[1]) + (v0[2] * v0[2] + v0[3] * v0[3]) + (v1[0] * v1[0] + v1[1] * v1[1]) + (v1[2] * v1[2] + v1[3] * v1[3]);
                    s += __shfl_xor(s, 16); s += __shfl_xor(s, 32);
                    if (fq == 0) atomicAdd(ss + row, s);
                }
            }
    }
    __device__ __forceinline__ void operator()(AccC acc, const Unit& u, int wr, int wc, int fr, int fq) const {
        const int pn = u.pn, rbase = u.pm * 256 + wr * 64 + fr, cb = 32 * wc + 4 * fq;
        if (pn < 4) { half<0, 0, false>(acc, qk, 1024, pn * 256 + cb, nullptr, rbase, fq); half<1, 0, false>(acc, qk, 1024, pn * 256 + 128 + cb, nullptr, rbase, fq); }
        else if (pn == 4) { half<0, 0, true>(acc, cq, 384, cb, ss_cq, rbase, fq); half<1, 0, true>(acc, cq, 384, 128 + cb, ss_cq, rbase, fq); }
        else if (pn == 5) { half<0, 0, true>(acc, cq, 384, 256 + cb, ss_cq, rbase, fq); half<1, 0, true>(acc, ckv, 256, cb, ss_ckv, rbase, fq); }
        else { half<0, 0, true>(acc, ckv, 256, 128 + cb, ss_ckv, rbase, fq); if (wc == 0) half<1, 1, false>(acc, kr, 32, 4 * fq, nullptr, rbase, fq); }
    }
};
struct Bf16R {
    static constexpr bool PERM = false, AFTER_DRAIN = false, HAS_MID = false;
    bf16_t* O; int ldc; const float* ss_row; float invn_row;
    __device__ __forceinline__ void operator()(AccC acc, const Unit& u, int wr, int wc, int fr, int fq) const {
        const int rbase = u.pm * 256 + wr * 64 + fr, cbase = u.pn * 256 + 32 * wc + 4 * fq;
#pragma unroll
        for (int ai = 0; ai < 2; ++ai)
#pragma unroll
            for (int m = 0; m < 4; ++m) {
                const int row = rbase + ai * 128 + m * 16;
                const float rs = ss_row ? __builtin_amdgcn_rsqf(ss_row[row] * invn_row + EPS) : 1.f;
#pragma unroll
                for (int bj = 0; bj < 2; ++bj)
#pragma unroll
                    for (int n = 0; n < 2; ++n) {
                        const f32x4 v = acc[ai][bj][m][n] * rs;
                        *(u32x2*)(O + (size_t)row * ldc + cbase + bj * 128 + n * 16) = (u32x2){pk_bf16(v[0], v[1]), pk_bf16(v[2], v[3])};
                    }
                asm volatile("" ::: "memory");
            }
    }
};
struct Bf16C {
    static constexpr bool PERM = false, AFTER_DRAIN = false, HAS_MID = false;
    bf16_t* O; int ldc; const float* ss_col; float invn_col;
    __device__ __forceinline__ void operator()(AccC acc, const Unit& u, int wr, int wc, int fr, int fq) const {
        const int rbase = u.pm * 256 + wr * 64 + fr, cbase = u.pn * 256 + 32 * wc + 4 * fq;
#pragma unroll
        for (int bj = 0; bj < 2; ++bj)
#pragma unroll
            for (int n = 0; n < 2; ++n) {
                const f32x4 q = *(const f32x4*)(ss_col + cbase + bj * 128 + n * 16); f32x4 cs;
#pragma unroll
                for (int i = 0; i < 4; ++i) cs[i] = __builtin_amdgcn_rsqf(q[i] * invn_col + EPS);
#pragma unroll
                for (int ai = 0; ai < 2; ++ai)
#pragma unroll
                    for (int m = 0; m < 4; ++m) {
                        const int row = rbase + ai * 128 + m * 16;
                        const f32x4 v = acc[ai][bj][m][n] * cs;
                        *(u32x2*)(O + (size_t)row * ldc + cbase + bj * 128 + n * 16) = (u32x2){pk_bf16(v[0], v[1]), pk_bf16(v[2], v[3])};
                    }
                asm volatile("" ::: "memory");
            }
    }
};
struct QMla {
    static constexpr bool PERM = false, AFTER_DRAIN = false, HAS_MID = false;
    bf16_t* O; const float* ss; const float *cosT, *sinT;
    __device__ __forceinline__ void operator()(AccC acc, const Unit& u, int wr, int wc, int fr, int fq) const {
        const int rbase = u.pm * 256 + wr * 64 + fr;
#pragma unroll
        for (int ai = 0; ai < 2; ++ai)
#pragma unroll
            for (int m = 0; m < 4; ++m) {
                const int row = rbase + ai * 128 + m * 16;
                const float rs = __builtin_amdgcn_rsqf(ss[row] * (1.f / QLORA) + EPS);
                const int pos = row_pos(row);
#pragma unroll
                for (int bj = 0; bj < 2; ++bj) {
                    const int colg = u.pn * 256 + bj * 128 + 32 * wc;
                    f32x4 v0 = acc[ai][bj][m][0] * rs, v1 = acc[ai][bj][m][1] * rs;
                    if (((colg >> 5) % 3) == 2) {
                        const f32x4 c = *(const f32x4*)(cosT + pos * 16 + 4 * fq), s = *(const f32x4*)(sinT + pos * 16 + 4 * fq);
                        const f32x4 a = v0 * c - v1 * s, b = v1 * c + v0 * s; v0 = a; v1 = b;
                    }
                    bf16_t* p = O + (size_t)row * 768 + colg + 4 * fq;
                    *(u32x2*)p = (u32x2){pk_bf16(v0[0], v0[1]), pk_bf16(v0[2], v0[3])};
                    *(u32x2*)(p + 16) = (u32x2){pk_bf16(v1[0], v1[1]), pk_bf16(v1[2], v1[3])};
                }
                asm volatile("" ::: "memory");
            }
    }
};
struct Wo {
    static constexpr bool PERM = false, AFTER_DRAIN = false, HAS_MID = true;
    float* O; const float *ss_sb, *ss_mla;
    __device__ __forceinline__ void mid(AccM acc, const Unit& u, int wr, int wc, int fr, int fq) const {
        int rbase = u.pm * 256 + wr * 64 + fr; asm volatile("" : "+v"(rbase) :: "memory");
#pragma unroll
        for (int ai = 0; ai < 2; ++ai)
#pragma unroll
            for (int m = 0; m < 4; ++m) {
                const int row = rbase + ai * 128 + m * 16;
                const float r = __builtin_amdgcn_rsqf(ss_sb[row] * (1.f / 512) + EPS) * __builtin_amdgcn_sqrtf(ss_mla[row] * (1.f / 512) + EPS);
#pragma unroll
                for (int bj = 0; bj < 2; ++bj)
#pragma unroll
                    for (int n = 0; n < 2; ++n) acc[ai][bj][m][n] *= r;
            }
    }
    __device__ __forceinline__ void operator()(AccC acc, const Unit& u, int wr, int wc, int fr, int fq) const {
        const int rbase = u.pm * 256 + wr * 64 + fr, cbase = u.pn * 256 + 32 * wc + 4 * fq;
#pragma unroll
        for (int ai = 0; ai < 2; ++ai)
#pragma unroll
            for (int m = 0; m < 4; ++m) {
                const int row = rbase + ai * 128 + m * 16;
                const float r = __builtin_amdgcn_rsqf(ss_mla[row] * (1.f / 512) + EPS);
#pragma unroll
                for (int bj = 0; bj < 2; ++bj)
#pragma unroll
                    for (int n = 0; n < 2; ++n) *(f32x4*)(O + (size_t)row * 1024 + cbase + bj * 128 + n * 16) = acc[ai][bj][m][n] * r;
            }
    }
};
struct GateUp {
    static constexpr bool PERM = false, AFTER_DRAIN = false, HAS_MID = false;
    bf16_t* O;
    __device__ __forceinline__ void operator()(AccC acc, const Unit& u, int wr, int wc, int fr, int fq) const {
        const int rbase = u.pm * 256 + wr * 64 + fr, cbase = u.pn * 128 + 16 * wc + 4 * fq;
#pragma unroll
        for (int ai = 0; ai < 2; ++ai)
#pragma unroll
            for (int m = 0; m < 4; ++m) {
                const int row = rbase + ai * 128 + m * 16;
#pragma unroll
                for (int bj = 0; bj < 2; ++bj) {
                    const f32x4 g = acc[ai][bj][m][0], up = acc[ai][bj][m][1]; f32x4 a;
#pragma unroll
                    for (int i = 0; i < 4; ++i) a[i] = g[i] * __builtin_amdgcn_rcpf(1.f + __builtin_amdgcn_exp2f(-1.44269504089f * g[i])) * up[i];
                    *(u32x2*)(O + (size_t)row * DFF + cbase + bj * 64) = (u32x2){pk_bf16(a[0], a[1]), pk_bf16(a[2], a[3])};
                }
            }
    }
};
struct F32Out {
    static constexpr bool PERM = false, AFTER_DRAIN = false, HAS_MID = false;
    float* O;
    __device__ __forceinline__ void operator()(AccC acc, const Unit& u, int wr, int wc, int fr, int fq) const {
        const int rbase = u.pm * 256 + wr * 64 + fr, cbase = u.pn * 256 + 32 * wc + 4 * fq;
#pragma unroll
        for (int ai = 0; ai < 2; ++ai)
#pragma unroll
            for (int m = 0; m < 4; ++m) {
                const int row = rbase + ai * 128 + m * 16;
#pragma unroll
                for (int bj = 0; bj < 2; ++bj)
#pragma unroll
                    for (int n = 0; n < 2; ++n) *(f32x4*)(O + (size_t)row * 1024 + cbase + bj * 128 + n * 16) = acc[ai][bj][m][n];
            }
    }
};
}

template <class Epi>
__device__ __forceinline__ void run_gemm(LAS unsigned char* lds, const bf16_t* A, int lda, const bf16_t* Bt, int ldb, int M, int N, int K, int kmid, int rot, const Epi& E, int wave_s) {
    pg8::Gemm g{A, Bt, M, N, K, lda, ldb, kmid};
    int bx = (int)blockIdx.x, G = (int)gridDim.x; asm volatile("" : "+s"(bx), "+s"(G));
    pg8::StaticOrder S; S.init(M, N, G, (bx + G - (rot % G)) % G);
    pg8::gemm_phase<Epi, pg8::StaticOrder, true, true>(lds, g, S, E, wave_s);
}

__device__ __forceinline__ void tr_item(const float* W, int ldw, int scol0, int k0, const float* kg0, const float* kg1, float scale, bf16_t* WT, int K, int drow0, int mode, LAS float* scr, int lane) {
#pragma unroll 8
    for (int i = 0; i < 32; ++i) {
        const int kk = 2 * i + (lane >> 5), k = k0 + kk; float g = scale;
        if (kg0) g *= (kg1 && k >= 512) ? kg1[k - 512] : kg0[k];
        scr[kk * 33 + (lane & 31)] = W[(size_t)k * ldw + scol0 + (lane & 31)] * g;
    }
    asm volatile("s_waitcnt lgkmcnt(0)" ::: "memory");
    const int c = lane & 7;
#pragma unroll
    for (int j = 0; j < 4; ++j) {
        const int n = (lane >> 3) + 8 * j; const LAS float* s = scr + (8 * c) * 33 + n;
        u32x4 o; o.x = pk_bf16(s[0 * 33], s[1 * 33]); o.y = pk_bf16(s[2 * 33], s[3 * 33]); o.z = pk_bf16(s[4 * 33], s[5 * 33]); o.w = pk_bf16(s[6 * 33], s[7 * 33]);
        const int drow = drow0 + (mode ? 32 * (n >> 4) + (n & 15) : n);
        *(u32x4*)(WT + (size_t)drow * K + k0 + 8 * c) = o;
    }
    asm volatile("s_waitcnt lgkmcnt(0)" ::: "memory");
}

constexpr float SCALE_QMLA = 0.10206207261596575f * 1.4426950408889634f;
constexpr int ITEMS_PER_LAYER = 6112;

__device__ __forceinline__ void convert_item(const Params& p, int layer, int it, LAS float* scr, int lane) {
    unsigned char* wl = p.ws + WS_W + (size_t)layer * W_LAYER;
    const float* w_in = p.in[2] + (size_t)layer * 1024 * 2208;
    constexpr int IT_SEG[12] = {0, 256, 512, 768, 1104, 1248, 1312, 1376, 1888, 3296, 4704, 6112};
    int seg = 0;
#pragma unroll
    for (int s = 1; s < 11; ++s) if (it >= IT_SEG[s]) seg = s;
    const int r = it - IT_SEG[seg];
    switch (seg) {
    case 0: { const int nb = r % 16, kb = r / 16; tr_item(w_in, 2208, 32 * nb, 64 * kb, nullptr, nullptr, 0.125f, (bf16_t*)(wl + W_MAIN), 1024, 32 * nb, 0, scr, lane); break; }
    case 1: { const int nb = r % 16, kb = r / 16; tr_item(w_in, 2208, 512 + 32 * nb, 64 * kb, nullptr, nullptr, 1.f, (bf16_t*)(wl + W_MAIN), 1024, 512 + 32 * nb, 0, scr, lane); break; }
    case 2: { const int nb = r % 16, kb = r / 16; tr_item(w_in, 2208, 1024 + 32 * nb, 64 * kb, nullptr, nullptr, 1.f, (bf16_t*)(wl + W_V), 1024, 32 * nb, 0, scr, lane); break; }
    case 3: { const int nb = r % 21, kb = r / 21; tr_item(w_in, 2208, 1536 + 32 * nb, 64 * kb, nullptr, nullptr, 1.f, (bf16_t*)(wl + W_MAIN), 1024, 1024 + 32 * nb, 0, scr, lane); break; }
    case 4: { const int nb = r % 24, kb = r / 24; tr_item(p.in[5] + (size_t)layer * 384 * 768, 768, 32 * nb, 64 * kb, p.in[3] + layer * 384, nullptr, SCALE_QMLA, (bf16_t*)(wl + W_UQ), 384, 32 * nb, 0, scr, lane); break; }
    case 5: { const int nb = r % 16, kb = r / 16; const int n0 = 32 * nb; tr_item(p.in[6] + (size_t)layer * 256 * 1024, 1024, 128 * (n0 >> 6) + (n0 & 63), 64 * kb, p.in[4] + layer * 256, nullptr, 1.f, (bf16_t*)(wl + W_UK), 256, n0, 0, scr, lane); break; }
    case 6: { const int nb = r % 16, kb = r / 16; const int n0 = 32 * nb; tr_item(p.in[6] + (size_t)layer * 256 * 1024, 1024, 128 * (n0 >> 6) + 64 + (n0 & 63), 64 * kb, p.in[4] + layer * 256, nullptr, 1.f, (bf16_t*)(wl + W_UV), 256, n0, 0, scr, lane); break; }
    case 7: { const int nb = r % 32, kb = r / 32; tr_item(p.in[9] + (size_t)layer * 1024 * 1024, 1024, 32 * nb, 64 * kb, p.in[7] + layer * 512, p.in[8] + layer * 512, 1.f, (bf16_t*)(wl + W_O), 1024, 32 * nb, 0, scr, lane); break; }
    case 8: { const int nb = r % 88, kb = r / 88; tr_item(p.in[14] + (size_t)layer * 1024 * DFF, DFF, 32 * nb, 64 * kb, nullptr, nullptr, 1.f, (bf16_t*)(wl + W_GU), 1024, 64 * nb, 1, scr, lane); break; }
    case 9: { const int nb = r % 88, kb = r / 88; tr_item(p.in[15] + (size_t)layer * 1024 * DFF, DFF, 32 * nb, 64 * kb, nullptr, nullptr, 1.f, (bf16_t*)(wl + W_GU), 1024, 64 * nb + 16, 1, scr, lane); break; }
    default: { const int nb = r % 32, kb = r / 32; tr_item(p.in[16] + (size_t)layer * DFF * 1024, 1024, 32 * nb, 64 * kb, nullptr, nullptr, 1.f, (bf16_t*)(wl + W_D), DFF, 32 * nb, 0, scr, lane); break; }
    }
}

__device__ __forceinline__ void sincos_f64(double a, double& s, double& c) {
    const double k = rint(a * 0.63661977236758134308);
    double r = fma(-k, 1.57079632679489655800e+00, a); r = fma(-k, 6.12323399573676603587e-17, r);
    const double r2 = r * r;
    double sp = -1.0 / 1307674368000.0; sp = fma(sp, r2, 1.0 / 6227020800.0); sp = fma(sp, r2, -1.0 / 39916800.0); sp = fma(sp, r2, 1.0 / 362880.0); sp = fma(sp, r2, -1.0 / 5040.0); sp = fma(sp, r2, 1.0 / 120.0); sp = fma(sp, r2, -1.0 / 6.0);
    const double sr = fma(sp * r2, r, r);
    double cp = 1.0 / 20922789888000.0; cp = fma(cp, r2, -1.0 / 87178291200.0); cp = fma(cp, r2, 1.0 / 479001600.0); cp = fma(cp, r2, -1.0 / 3628800.0); cp = fma(cp, r2, 1.0 / 40320.0); cp = fma(cp, r2, -1.0 / 720.0); cp = fma(cp, r2, 1.0 / 24.0); cp = fma(cp, r2, -0.5);
    const double cr = fma(cp, r2, 1.0);
    const int q = ((int)k) & 3;
    s = (q == 0) ? sr : (q == 1) ? cr : (q == 2) ? -sr : -cr;
    c = (q == 0) ? cr : (q == 1) ? -sr : (q == 2) ? -cr : sr;
}

template <int R>
__device__ __forceinline__ void row_step(const float* const (&y)[R], const float* gy, float* const (&hrow)[R], const float* const (&hsrc)[R], const float* gx, bf16_t* const (&xn)[R], bool has_y, bool has_xn, int lane) {
    f32x4 v[R][4], t[R][4];
#pragma unroll
    for (int r = 0; r < R; ++r)
#pragma unroll
        for (int j = 0; j < 4; ++j) { v[r][j] = *((const f32x4*)hsrc[r] + lane + 64 * j); if (has_y) t[r][j] = *((const f32x4*)y[r] + lane + 64 * j); }
    if (has_y) {
        f32x4 g[4];
#pragma unroll
        for (int j = 0; j < 4; ++j) g[j] = *((const f32x4*)gy + lane + 64 * j);
        float s[R];
#pragma unroll
        for (int r = 0; r < R; ++r) { s[r] = 0.f;
#pragma unroll
            for (int j = 0; j < 4; ++j) s[r] += (t[r][j][0] * t[r][j][0] + t[r][j][1] * t[r][j][1]) + (t[r][j][2] * t[r][j][2] + t[r][j][3] * t[r][j][3]); }
#pragma unroll
        for (int o = 1; o < 64; o <<= 1)
#pragma unroll
            for (int r = 0; r < R; ++r) s[r] += __shfl_xor(s[r], o);
#pragma unroll
        for (int r = 0; r < R; ++r) { const float rs = 1.0f / sqrtf(s[r] * (1.f / DM) + EPS);
#pragma unroll
            for (int j = 0; j < 4; ++j) v[r][j] += t[r][j] * rs * g[j]; }
    }
#pragma unroll
    for (int r = 0; r < R; ++r)
#pragma unroll
        for (int j = 0; j < 4; ++j) *((f32x4*)hrow[r] + lane + 64 * j) = v[r][j];
    if (has_xn) {
        f32x4 g[4];
#pragma unroll
        for (int j = 0; j < 4; ++j) g[j] = *((const f32x4*)gx + lane + 64 * j);
        float s[R];
#pragma unroll
        for (int r = 0; r < R; ++r) { s[r] = 0.f;
#pragma unroll
            for (int j = 0; j < 4; ++j) s[r] += (v[r][j][0] * v[r][j][0] + v[r][j][1] * v[r][j][1]) + (v[r][j][2] * v[r][j][2] + v[r][j][3] * v[r][j][3]); }
#pragma unroll
        for (int o = 1; o < 64; o <<= 1)
#pragma unroll
            for (int r = 0; r < R; ++r) s[r] += __shfl_xor(s[r], o);
#pragma unroll
        for (int r = 0; r < R; ++r) { const float rs = 1.0f / sqrtf(s[r] * (1.f / DM) + EPS);
#pragma unroll
            for (int j = 0; j < 4; ++j) { const f32x4 o = v[r][j] * rs * g[j]; *((u32x2*)xn[r] + lane + 64 * j) = (u32x2){pk_bf16(o[0], o[1]), pk_bf16(o[2], o[3])}; } }
    }
}
__device__ __forceinline__ float* h_row(const Params& p, int row) { return row < TREAL ? p.out + (size_t)row * DM : (float*)(p.ws + WS_HMETA) + (size_t)(row - TREAL) * DM; }

__device__ __forceinline__ void phase_prologue(const Params& p, LAS unsigned char* lds, int wave_s) {
    int tid_ = phase_tid(wave_s);
    const int tid = tid_, lane = tid & 63, wave = tid >> 6, G = gridDim.x;
    const int gt = blockIdx.x * NTHR + tid, NGT = G * NTHR, gw = blockIdx.x * NWAVE + wave, NGW = G * NWAVE;
    float* ss = (float*)(p.ws + WS_SS);
    for (size_t i = gt; i < SS_FLOATS; i += NGT) ss[i] = 0.f;
    float* cosT = (float*)(p.ws + WS_ROPE); float* sinT = cosT + LPOS * 16;
    for (int i = gt; i < LPOS * 16; i += NGT) { const int pos = i >> 4, j = i & 15; const float ang = (float)pos * p.inv_freq[j]; double s, c; sincos_f64((double)ang, s, c); cosT[i] = (float)c; sinT[i] = (float)s; }
    for (int l = 0; l < 2; ++l) {
        u32x4* z = (u32x4*)(p.ws + WS_W + (size_t)l * W_LAYER + W_MAIN + 1696ull * 1024 * 2);
        for (int i = gt; i < 96 * 1024 * 2 / 16; i += NGT) z[i] = (u32x4){0u, 0u, 0u, 0u};
    }
    LAS float* scr = (LAS float*)(lds + wave * 16384);
    for (int it = gw; it < 2 * ITEMS_PER_LAYER; it += NGW) { const int layer = it >= ITEMS_PER_LAYER ? 1 : 0; convert_item(p, layer, it - layer * ITEMS_PER_LAYER, scr, lane); }
    bf16_t* xn = (bf16_t*)(p.ws + WS_XN);
    constexpr int RR = 4;
    for (int row0 = gw * RR; row0 < TTOT; row0 += NGW * RR) {
        const float* src[RR]; float* hr[RR]; bf16_t* xr[RR]; const float* yy[RR];
#pragma unroll
        for (int r = 0; r < RR; ++r) { const int row = row0 + r; src[r] = row < TREAL ? p.in[0] + (size_t)row * DM : p.in[1] + (size_t)((row - TREAL) & 15) * DM; hr[r] = h_row(p, row); xr[r] = xn + (size_t)row * DM; yy[r] = nullptr; }
        row_step<RR>(yy, nullptr, hr, src, p.in[10], xr, false, true, lane);
    }
}
__device__ __forceinline__ void phase_rows(const Params& p, const float* y, const float* gy, const float* gx, bool make_xn, int nrows, int wave_s) {
    int tid_ = phase_tid(wave_s);
    const int tid = tid_, lane = tid & 63, wave = tid >> 6, gw = blockIdx.x * NWAVE + wave, NGW = gridDim.x * NWAVE;
    bf16_t* xn = (bf16_t*)(p.ws + WS_XN);
    constexpr int RR = 4;
    for (int row0 = gw * RR; row0 < nrows; row0 += NGW * RR) {
        const float* src[RR]; float* hr[RR]; bf16_t* xr[RR]; const float* yy[RR];
#pragma unroll
        for (int r = 0; r < RR; ++r) { const int row = row0 + r; hr[r] = h_row(p, row); src[r] = hr[r]; xr[r] = xn + (size_t)row * DM; yy[r] = y + (size_t)row * DM; }
        row_step<RR>(yy, gy, hr, src, gx, xr, true, make_xn, lane);
    }
}

namespace att {
constexpr int KS_SB = 144, KS_ML = 208, VS = 144;
constexpr int KB0 = 0, KBSZ = 64 * KS_ML, VB0 = 2 * KBSZ, VBSZ = 64 * VS, FLG = VB0 + 2 * VBSZ;
__device__ __forceinline__ int pi_row(int m) { return 16 * (m >> 4) + 8 * ((m >> 2) & 1) + 4 * ((m >> 3) & 1) + (m & 3); }
#define MFMA32(a, b, c) __builtin_amdgcn_mfma_f32_32x32x16_bf16(a, b, c, 0, 0, 0)
__device__ __forceinline__ bf16x8 pack8(const f32x16& s, int o) {
    u32x4 w; w.x = pk_bf16(s[o + 0], s[o + 1]); w.y = pk_bf16(s[o + 2], s[o + 3]); w.z = pk_bf16(s[o + 4], s[o + 5]); w.w = pk_bf16(s[o + 6], s[o + 7]);
    return __builtin_bit_cast(bf16x8, w);
}
__device__ __forceinline__ void store_o(const f32x16& o0, const f32x16& o1, float inv, bf16_t* orow, float* ssrow, int hi, bool valid) {
    float ssq = 0.f;
#pragma unroll
    for (int db = 0; db < 2; ++db)
#pragma unroll
        for (int a = 0; a < 4; ++a) {
            const f32x16& o = db ? o1 : o0;
            const float v0 = o[4 * a] * inv, v1 = o[4 * a + 1] * inv, v2 = o[4 * a + 2] * inv, v3 = o[4 * a + 3] * inv;
            ssq += (v0 * v0 + v1 * v1) + (v2 * v2 + v3 * v3);
            if (valid) *(u32x2*)(orow + 32 * db + 8 * a + 4 * hi) = (u32x2){pk_bf16(v0, v1), pk_bf16(v2, v3)};
        }
    ssq += __shfl_xor(ssq, 32);
    if (valid && hi == 0) atomicAdd(ssrow, ssq);
}

__device__ __forceinline__ void mla_unit(int wave_s, LAS unsigned char* lds, const bf16_t* Q, const bf16_t* Kn, const bf16_t* Kr, const bf16_t* VT, bf16_t* O, float* ss, int b, int h, int qb) {
    int tid_ = phase_tid(wave_s);
    const int tid = tid_, lane = tid & 63, w = __builtin_amdgcn_readfirstlane(tid >> 6), ql = lane & 31, hi = lane >> 5;
    const bool meta = qb < 0;
    const int qrow = meta ? (TREAL + b * 16 + (ql & 15)) : (b * SEQ + qb * 256 + w * 32 + ql);
    const int qt = meta ? ql : (qb * 256 + w * 32 + ql);
    bf16x8 qf[6];
#pragma unroll
    for (int ks = 0; ks < 6; ++ks) qf[ks] = *(const bf16x8*)(Q + (size_t)qrow * 768 + h * 96 + (2 * ks + hi) * 8);
    const int ntiles = meta ? 1 : 4 * qb + 5;
    const int wlast = meta ? (w == 0 ? 0 : -1) : 1 + 4 * qb + (w >> 1);
    const int krow = tid >> 3, kch = tid & 7, rrow = tid >> 2, rch = tid & 3;
    const unsigned aoff = (unsigned)(pi_row(ql) * KS_ML + hi * 16), voff = (unsigned)(ql * VS + hi * 16);
    float mrun = -INFINITY, lrun = 0.f;
    f32x16 o0, o1;
#pragma unroll
    for (int i = 0; i < 16; ++i) { o0[i] = 0.f; o1[i] = 0.f; }
    struct TR { u32x4 k, r, v; };
    TR RA, RB; RA.r = (u32x4){0u, 0u, 0u, 0u}; RB.r = RA.r;
    auto gload = [&](TR& t, int i) {
        const int row0 = (i == 0) ? TREAL + b * 16 : b * SEQ + 64 * (i - 1);
        t.k = *(const u32x4*)(Kn + (size_t)(row0 + krow) * 512 + h * 64 + kch * 8);
        if (tid < 256) t.r = *(const u32x4*)(Kr + (size_t)(row0 + rrow) * 32 + rch * 8);
        t.v = *(const u32x4*)(VT + (size_t)(h * 64 + krow) * MP + row0 + kch * 8);
    };
    auto lstore = [&](const TR& t, int buf) {
        *(LAS u32x4*)(lds + KB0 + buf * KBSZ + krow * KS_ML + kch * 16) = t.k;
        if (tid < 256) *(LAS u32x4*)(lds + KB0 + buf * KBSZ + rrow * KS_ML + 128 + rch * 16) = t.r;
        *(LAS u32x4*)(lds + VB0 + buf * VBSZ + krow * VS + kch * 16) = t.v;
    };
    auto step = [&](int i, TR& X, TR& Y) {
        const int buf = i & 1;
        if (i + 2 < ntiles) gload(Y, i + 2);
        if (i <= wlast) {
            const LAS unsigned char* kb = lds + KB0 + buf * KBSZ + aoff; const LAS unsigned char* vb = lds + VB0 + buf * VBSZ + voff;
            f32x16 s0, s1;
#pragma unroll
            for (int r = 0; r < 16; ++r) { s0[r] = 0.f; s1[r] = 0.f; }
#pragma unroll
            for (int ks = 0; ks < 6; ++ks) {
                const bf16x8 a0 = *(const LAS bf16x8*)(kb + ks * 32), a1 = *(const LAS bf16x8*)(kb + 32 * KS_ML + ks * 32);
                s0 = MFMA32(a0, qf[ks], s0); s1 = MFMA32(a1, qf[ks], s1);
            }
            const int lim = (i == 0) ? (meta ? (ql < 15 ? ql : 15) : 15) : qt - 64 * (i - 1);
            if (__ballot(lim < 63) != 0ull) {
#pragma unroll
                for (int r = 0; r < 16; ++r) { const int ki = 16 * (r >> 3) + 8 * hi + (r & 7); if (ki > lim) s0[r] = -INFINITY; if (ki + 32 > lim) s1[r] = -INFINITY; }
            }
            float mx = fmaxf(s0[0], s1[0]);
#pragma unroll
            for (int r = 1; r < 16; ++r) mx = fmaxf(mx, fmaxf(s0[r], s1[r]));
            mx = fmaxf(mx, __shfl_xor(mx, 32));
            const float mn = fmaxf(mrun, mx);
            if (__ballot(mn > mrun) != 0ull) {
                const float alpha = __builtin_amdgcn_exp2f(mrun - mn); lrun *= alpha;
#pragma unroll
                for (int r = 0; r < 16; ++r) { o0[r] *= alpha; o1[r] *= alpha; }
            }
            mrun = mn;
            float rs = 0.f;
#pragma unroll
            for (int r = 0; r < 16; ++r) { s0[r] = __builtin_amdgcn_exp2f(s0[r] - mn); s1[r] = __builtin_amdgcn_exp2f(s1[r] - mn); rs += s0[r] + s1[r]; }
            lrun += rs;
#pragma unroll
            for (int s = 0; s < 4; ++s) {
                const bf16x8 pf = pack8((s >> 1) ? s1 : s0, 8 * (s & 1));
                const bf16x8 v0 = *(const LAS bf16x8*)(vb + s * 32), v1 = *(const LAS bf16x8*)(vb + 32 * VS + s * 32);
                o0 = MFMA32(v0, pf, o0); o1 = MFMA32(v1, pf, o1);
            }
        }
        if (i + 1 < ntiles) lstore(X, buf ^ 1);
        __syncthreads();
    };
    gload(RB, 0); lstore(RB, 0); if (ntiles > 1) gload(RA, 1); __syncthreads();
    for (int i = 0; i < ntiles; i += 2) { step(i, RA, RB); if (i + 1 < ntiles) step(i + 1, RB, RA); }
    lrun += __shfl_xor(lrun, 32);
    const bool valid = meta ? (w == 0 && ql < 16) : true;
    store_o(o0, o1, 1.0f / lrun, O + (size_t)qrow * 1024 + 512 + h * 64, ss + qrow, hi, valid);
}

__device__ __forceinline__ void sb_unit(int wave_s, LAS unsigned char* lds, const bf16_t* QK, const bf16_t* VT, bf16_t* O, float* ss, int b, int h, int qb) {
    int tid_ = phase_tid(wave_s);
    const int tid = tid_, lane = tid & 63, w = __builtin_amdgcn_readfirstlane(tid >> 6), ql = lane & 31, hi = lane >> 5;
    const bool meta = qb < 0;
    const int qrow = meta ? (TREAL + b * 16 + (ql & 15)) : (b * SEQ + qb * 256 + w * 32 + ql);
    const int qt = meta ? ql : (qb * 256 + w * 32 + ql);
    bf16x8 qf[4];
#pragma unroll
    for (int ks = 0; ks < 4; ++ks) qf[ks] = *(const bf16x8*)(QK + (size_t)qrow * 1024 + h * 64 + (2 * ks + hi) * 8);
    const int ntiles = meta ? 1 : 4 * qb + 5;
    const int wfirst = meta ? (w == 0 ? 0 : 1) : 3 - (w >> 1);
    const int krow = tid >> 3, kch = tid & 7;
    const unsigned aoff = (unsigned)(pi_row(ql) * KS_SB + hi * 16), voff = (unsigned)(ql * VS + hi * 16);
    f32x16 o0, o1;
#pragma unroll
    for (int i = 0; i < 16; ++i) { o0[i] = 0.f; o1[i] = 0.f; }
    float carry = 0.f;
    struct TR { u32x4 k, v; };
    TR RA, RB;
    auto gload = [&](TR& t, int i) {
        const int row0 = (meta || i == ntiles - 1) ? TREAL + b * 16 : b * SEQ + 64 * (4 * qb + 3 - i);
        t.k = *(const u32x4*)(QK + (size_t)(row0 + krow) * 1024 + 512 + h * 64 + kch * 8);
        t.v = *(const u32x4*)(VT + (size_t)(h * 64 + krow) * MP + row0 + kch * 8);
    };
    auto lstore = [&](const TR& t, int buf) {
        *(LAS u32x4*)(lds + KB0 + buf * KBSZ + krow * KS_SB + kch * 16) = t.k;
        *(LAS u32x4*)(lds + VB0 + buf * VBSZ + krow * VS + kch * 16) = t.v;
    };
    LAS int* flg = (LAS int*)(lds + FLG);
    auto step = [&](int i, TR& X, TR& Y) -> bool {
        const int buf = i & 1;
        if (i > 0) {
            int all = 1;
#pragma unroll
            for (int k = 0; k < NWAVE; ++k) all &= flg[(buf ^ 1) * NWAVE + k];
            if (all) return true;
        }
        if (i + 2 < ntiles) gload(Y, i + 2);
        if (i >= wfirst) {
            const LAS unsigned char* kb = lds + KB0 + buf * KBSZ + aoff; const LAS unsigned char* vb = lds + VB0 + buf * VBSZ + voff;
            f32x16 s0, s1, l0, l1;
#pragma unroll
            for (int r = 0; r < 16; ++r) { s0[r] = 0.f; s1[r] = 0.f; }
#pragma unroll
            for (int ks = 0; ks < 4; ++ks) {
                const bf16x8 a0 = *(const LAS bf16x8*)(kb + ks * 32), a1 = *(const LAS bf16x8*)(kb + 32 * KS_SB + ks * 32);
                s0 = MFMA32(a0, qf[ks], s0); s1 = MFMA32(a1, qf[ks], s1);
            }
            const bool mtile = meta || i == ntiles - 1;
            const int lim = mtile ? (meta ? (ql < 16 ? ql - 1 : 15) : 15) : qt - 64 * (4 * qb + 3 - i) - 1;
#pragma unroll
            for (int r = 0; r < 16; ++r) {
                const int ki = 16 * (r >> 3) + 8 * hi + (r & 7);
                { const float z = s0[r], sp = fmaxf(z, 0.f) + 0.69314718056f * __builtin_amdgcn_logf(1.f + __builtin_amdgcn_exp2f(-1.44269504089f * fabsf(z))); const bool ok = ki <= lim; l0[r] = ok ? -sp : 0.f; s0[r] = ok ? z : -INFINITY; }
                { const float z = s1[r], sp = fmaxf(z, 0.f) + 0.69314718056f * __builtin_amdgcn_logf(1.f + __builtin_amdgcn_exp2f(-1.44269504089f * fabsf(z))); const bool ok = ki + 32 <= lim; l1[r] = ok ? -sp : 0.f; s1[r] = ok ? z : -INFINITY; }
            }
            float og[4], pg[4];
#pragma unroll
            for (int q = 0; q < 4; ++q) { const f32x16& l = (q >> 1) ? l1 : l0; const int o = 8 * (q & 1);
                og[q] = ((l[o] + l[o + 1]) + (l[o + 2] + l[o + 3])) + ((l[o + 4] + l[o + 5]) + (l[o + 6] + l[o + 7])); pg[q] = __shfl_xor(og[q], 32); }
            float tail = carry;
#pragma unroll
            for (int q = 3; q >= 0; --q) {
                f32x16& l = (q >> 1) ? l1 : l0; f32x16& s = (q >> 1) ? s1 : s0; const int o = 8 * (q & 1);
                float run = tail + (hi == 0 ? pg[q] : 0.f);
#pragma unroll
                for (int j = 7; j >= 0; --j) { const float lm = l[o + j]; s[o + j] = __builtin_amdgcn_exp2f(1.44269504089f * (s[o + j] + lm + run)); run += lm; }
                tail += og[q] + pg[q];
            }
            carry = tail;
#pragma unroll
            for (int s = 0; s < 4; ++s) {
                const bf16x8 pf = pack8((s >> 1) ? s1 : s0, 8 * (s & 1));
                const bf16x8 v0 = *(const LAS bf16x8*)(vb + s * 32), v1 = *(const LAS bf16x8*)(vb + 32 * VS + s * 32);
                o0 = MFMA32(v0, pf, o0); o1 = MFMA32(v1, pf, o1);
            }
        }
        { const int dn = (__ballot(carry >= -104.0f) == 0ull) ? 1 : 0; if (lane == 0) flg[buf * NWAVE + w] = dn; }
        if (i + 1 < ntiles) lstore(X, buf ^ 1);
        __syncthreads();
        return false;
    };
    gload(RB, 0); lstore(RB, 0); if (ntiles > 1) gload(RA, 1); __syncthreads();
    for (int i = 0; i < ntiles; i += 2) { if (step(i, RA, RB)) break; if (i + 1 < ntiles) { if (step(i + 1, RB, RA)) break; } }
    __syncthreads();
    const bool valid = meta ? (w == 0 && ql < 16) : true;
    store_o(o0, o1, 1.0f, O + (size_t)qrow * 1024 + h * 64, ss + qrow, hi, valid);
}

__device__ __forceinline__ void phase_attention(const Params& p, LAS unsigned char* lds, int layer, int wave_s) {
    unsigned char* g = p.ws + WS_G;
    const bf16_t* QK = (const bf16_t*)(g + G_QK); const bf16_t* VTS = (const bf16_t*)(g + G_VTS);
    const bf16_t* QM = (const bf16_t*)(g + G_QM); const bf16_t* KN = (const bf16_t*)(g + G_KN); const bf16_t* KR = (const bf16_t*)(g + G_KR); const bf16_t* VTM = (const bf16_t*)(g + G_VTM);
    bf16_t* O = (bf16_t*)(g + G_O);
    float* ss_sb = (float*)(p.ws + WS_SS) + (size_t)(layer * 4 + 2) * MP; float* ss_ml = ss_sb + MP;
    const int nunits = layer == 1 ? 2048 : 2176;
    for (int idx = blockIdx.x; idx < nunits; idx += gridDim.x) {
        if (idx < 1024) {
            const int rnd = idx >> 8, cc = idx & 255, grp = cc >> 6, bh = cc & 63;
            const int qb = rnd == 0 ? 15 - grp : rnd == 1 ? 8 + grp : rnd == 2 ? 7 - grp : grp;
            mla_unit(wave_s, lds, QM, KN, KR, VTM, O, ss_ml, bh >> 3, bh & 7, qb);
        } else if (idx < 2048) {
            const int k = idx - 1024, bh = k & 63, qb = k >> 6;
            sb_unit(wave_s, lds, QK, VTS, O, ss_sb, bh >> 3, bh & 7, qb);
        } else if (idx < 2112) { const int bh = idx - 2048; mla_unit(wave_s, lds, QM, KN, KR, VTM, O, ss_ml, bh >> 3, bh & 7, -1); }
        else { const int bh = idx - 2112; sb_unit(wave_s, lds, QK, VTS, O, ss_sb, bh >> 3, bh & 7, -1); }
    }
}
}


__device__ __forceinline__ void grid_barrier(unsigned* cnt, unsigned target) {
    asm volatile("s_waitcnt vmcnt(0) lgkmcnt(0)" ::: "memory");
    __syncthreads();
    if (threadIdx.x == 0) {
        __builtin_amdgcn_fence(__ATOMIC_RELEASE, "agent");
        asm volatile("s_waitcnt vmcnt(0)" ::: "memory");
        __hip_atomic_fetch_add(cnt, 1u, __ATOMIC_RELAXED, __HIP_MEMORY_SCOPE_AGENT);
        while (__hip_atomic_load(cnt, __ATOMIC_RELAXED, __HIP_MEMORY_SCOPE_AGENT) < target) __builtin_amdgcn_s_sleep(1);
        __builtin_amdgcn_fence(__ATOMIC_ACQUIRE, "agent");
        asm volatile("s_waitcnt vmcnt(0)" ::: "memory");
    }
    __syncthreads();
}

__global__ void __launch_bounds__(NTHR) hybrid_fwd(Params p) {
    extern __shared__ __attribute__((aligned(16))) unsigned char smem[];
    LAS unsigned char* lds = (LAS unsigned char*)smem;
    cg::grid_group grid = cg::this_grid();
    const int wave_s = __builtin_amdgcn_readfirstlane((int)threadIdx.x >> 6);
    unsigned char* ws = p.ws; unsigned char* g = ws + WS_G;
    const float* cosT = (const float*)(ws + WS_ROPE); const float* sinT = cosT + LPOS * 16;
    bf16_t* xn = (bf16_t*)(ws + WS_XN);
    const int lo = p.ph_lo, hi = p.ph_hi;
    int ph = 0, nbar = 0;
    unsigned* bar_cnt = (unsigned*)(ws + WS_HMETA + 200ull * 1024 * 4);
    if (blockIdx.x == 0 && threadIdx.x == 0) __hip_atomic_store(bar_cnt, 0u, __ATOMIC_RELAXED, __HIP_MEMORY_SCOPE_AGENT);
#ifndef PHMASK
#define PHMASK 0xFFFFFFFFu
#endif
#define PHASE_BEGIN if (ph >= lo && ph < hi) {
#define PHASE_END   if (ph + 1 < hi) { if (ph == lo) grid.sync(); else grid_barrier(bar_cnt, (unsigned)(++nbar) * gridDim.x); } } ++ph;

    PHASE_BEGIN if (PHMASK & 1u) phase_prologue(p, lds, wave_s); PHASE_END
    for (int layer = 0; layer < 2; ++layer) {
        unsigned char* wl = ws + WS_W + (size_t)layer * W_LAYER;
        float* ssb = (float*)(ws + WS_SS) + (size_t)layer * 4 * MP;
        float *ss_cq = ssb, *ss_ckv = ssb + MP, *ss_osb = ssb + 2 * MP, *ss_oml = ssb + 3 * MP;
        const int Mrows = layer == 1 ? TREAL : MP, nrows = layer == 1 ? TREAL : TTOT;
        PHASE_BEGIN if (PHMASK & 2u) {
            epi::Main E{(bf16_t*)(g + G_QK), (bf16_t*)(g + G_CQ), (bf16_t*)(g + G_CKV), (bf16_t*)(g + G_KR), ss_cq, ss_ckv, cosT, sinT};
#ifndef NO_A
            run_gemm(lds, xn, 1024, (const bf16_t*)(wl + W_MAIN), 1024, MP, NMAIN, 1024, -1, 0, E, wave_s);
#endif
            epi::Bf16R EV{(bf16_t*)(g + G_VTS), MP, nullptr, 0.f};
#ifndef NO_B
            run_gemm(lds, (const bf16_t*)(wl + W_V), 1024, xn, 1024, 512, MP, 1024, -1, 136, EV, wave_s);
#endif
 }
        PHASE_END
        PHASE_BEGIN if (PHMASK & 4u) {
            epi::QMla EQ{(bf16_t*)(g + G_QM), ss_cq, cosT, sinT};
#ifndef NO_A
            run_gemm(lds, (const bf16_t*)(g + G_CQ), 384, (const bf16_t*)(wl + W_UQ), 384, MP, 768, 384, -1, 0, EQ, wave_s);
#endif
            epi::Bf16R EK{(bf16_t*)(g + G_KN), 512, ss_ckv, 1.f / KVLORA};
#ifndef NO_B
            run_gemm(lds, (const bf16_t*)(g + G_CKV), 256, (const bf16_t*)(wl + W_UK), 256, MP, 512, 256, -1, 128, EK, wave_s);
#endif
            epi::Bf16C EV{(bf16_t*)(g + G_VTM), MP, ss_ckv, 1.f / KVLORA};
#ifndef NO_C
            run_gemm(lds, (const bf16_t*)(wl + W_UV), 256, (const bf16_t*)(g + G_CKV), 256, 512, MP, 256, -1, 136, EV, wave_s);
#endif
 }
        PHASE_END
        PHASE_BEGIN if (PHMASK & 8u) att::phase_attention(p, lds, layer, wave_s); PHASE_END
        PHASE_BEGIN if (PHMASK & 16u) {
            epi::Wo E{(float*)(g + G_MIX), ss_osb, ss_oml};
            run_gemm(lds, (const bf16_t*)(g + G_O), 1024, (const bf16_t*)(wl + W_O), 1024, Mrows, 1024, 1024, 8, 0, E, wave_s); }
        PHASE_END
        PHASE_BEGIN if (PHMASK & 32u) phase_rows(p, (const float*)(g + G_MIX), p.in[11] + layer * DM, p.in[12] + layer * DM, true, nrows, wave_s); PHASE_END
        PHASE_BEGIN if (PHMASK & 64u) {
            epi::GateUp E{(bf16_t*)(g + G_ACT)};
            run_gemm(lds, xn, 1024, (const bf16_t*)(wl + W_GU), 1024, Mrows, NGU, 1024, -1, 0, E, wave_s); }
        PHASE_END
        PHASE_BEGIN if (PHMASK & 128u) {
            epi::F32Out E{(float*)(g + G_FFN)};
            run_gemm(lds, (const bf16_t*)(g + G_ACT), DFF, (const bf16_t*)(wl + W_D), DFF, Mrows, 1024, DFF, -1, 0, E, wave_s); }
        PHASE_END
        PHASE_BEGIN if (PHMASK & 256u) phase_rows(p, (const float*)(g + G_FFN), p.in[13] + layer * DM, p.in[10] + (layer < 1 ? (layer + 1) * DM : 0), layer < 1, nrows, wave_s); PHASE_END
    }
}
constexpr int N_PHASES = 17;

#ifdef DBG_STOP
__global__ void __launch_bounds__(256) dbg_dump(Params p) {
    unsigned char* g = p.ws + WS_G;
    const size_t n = (size_t)TREAL * DM;
    for (size_t i = (size_t)blockIdx.x * 256 + threadIdx.x; i < n; i += (size_t)gridDim.x * 256) {
        const size_t row = i >> 10, c = i & 1023; float v = 0.f;
        auto bf = [](const unsigned char* b, size_t idx) { return __uint_as_float((unsigned)((const bf16_t*)b)[idx] << 16); };
#if DBG_DUMP == 1
        v = bf(g + G_QK, row * 1024 + c) + bf(g + G_CQ, row * 384 + c % 384) + bf(g + G_CKV, row * 256 + c % 256) + bf(g + G_KR, row * 32 + c % 32) + bf(g + G_VTS, (c % 512) * MP + row)
          + ((const float*)(p.ws + WS_SS))[row] + ((const float*)(p.ws + WS_SS))[MP + row];
#elif DBG_DUMP == 2
        v = bf(g + G_QM, row * 768 + c % 768) + bf(g + G_KN, row * 512 + c % 512) + bf(g + G_VTM, (c % 512) * MP + row);
#elif DBG_DUMP == 3
        v = bf(g + G_O, row * 1024 + c);
#elif DBG_DUMP == 31
        v = c < 512 ? bf(g + G_O, row * 1024 + c) : 0.f;
#elif DBG_DUMP == 32
        v = c >= 512 ? bf(g + G_O, row * 1024 + c) : 0.f;
#elif DBG_DUMP == 4
        v = ((const float*)(g + G_MIX))[row * 1024 + c];
#elif DBG_DUMP == 5
        v = bf(p.ws + WS_XN, row * 1024 + c);
#elif DBG_DUMP == 6
        v = bf(g + G_ACT, row * DFF + c) + bf(g + G_ACT, row * DFF + 1024 + c) + bf(g + G_ACT, row * DFF + 1792 + c);
#elif DBG_DUMP == 7
        v = ((const float*)(g + G_FFN))[row * 1024 + c];
#endif
#ifdef DBG_SAN
        if (!(fabsf(v) < 1e30f)) v = 12345.f;
#endif
        p.out[i] = v;
    }
}
#endif

extern "C" void kernel_launch(void* const* d_in, const int* in_sizes, int n_in, void* d_out, int out_size, void* d_ws, size_t ws_size, hipStream_t stream) {
    static int grid = 0;
    if (grid == 0) {
        if (n_in != 17 || ws_size < WS_END) { fprintf(stderr, "kernel_launch: need 17 inputs and %zu bytes of workspace (got %d, %zu)\n", (size_t)WS_END, n_in, ws_size); grid = -1; return; }
        int dev = 0, cus = 0, per_cu = 0;
        (void)hipGetDevice(&dev); (void)hipDeviceGetAttribute(&cus, hipDeviceAttributeMultiprocessorCount, dev);
        (void)hipFuncSetAttribute((const void*)hybrid_fwd, hipFuncAttributeMaxDynamicSharedMemorySize, LDS_BYTES);
        (void)hipOccupancyMaxActiveBlocksPerMultiprocessor(&per_cu, (const void*)hybrid_fwd, NTHR, LDS_BYTES);
        if (per_cu < 1) { fprintf(stderr, "kernel_launch: occupancy query says %d blocks per CU\n", per_cu); per_cu = 1; }
        (void)hipGetLastError();
        grid = cus * 1;
    }
    if (grid < 0) return;
    Params p; memset(&p, 0, sizeof(p));
    for (int i = 0; i < 17; ++i) p.in[i] = (const float*)d_in[i];
    p.out = (float*)d_out; p.ws = (unsigned char*)d_ws;
    for (int i = 0; i < 16; ++i) p.inv_freq[i] = 1.0f / powf(10000.0f, (float)(2 * i) / 32.0f);
#ifndef MK_LAUNCHES
#define MK_LAUNCHES 1
#endif
    if (MK_LAUNCHES == 1) {
        p.ph_lo = 0; p.ph_hi = N_PHASES;
        void* args[] = {&p};
        hipError_t e = hipLaunchCooperativeKernel((const void*)hybrid_fwd, dim3(grid), dim3(NTHR), args, LDS_BYTES, stream);
        if (e != hipSuccess) fprintf(stderr, "cooperative launch failed: %s (grid %d)\n", hipGetErrorString(e), grid);
    } else {
#ifdef DBG_STOP
        for (int k = 0; k < DBG_STOP; ++k) { p.ph_lo = k; p.ph_hi = k + 1; hipLaunchKernelGGL(hybrid_fwd, dim3(grid), dim3(NTHR), LDS_BYTES, stream, p); }
        hipLaunchKernelGGL(dbg_dump, dim3(2048), dim3(256), 0, stream, p);
#else
        for (int k = 0; k < N_PHASES; ++k) { p.ph_lo = k; p.ph_hi = k + 1; hipLaunchKernelGGL(hybrid_fwd, dim3(grid), dim3(NTHR), LDS_BYTES, stream, p); }
#endif
    }
}
```

```cpp
#include <hip/hip_runtime.h>
#include <hip/hip_cooperative_groups.h>
#include <cstdio>
#include <cstdint>
#include <cmath>
#include <cstring>
namespace cg = cooperative_groups;

__device__ __forceinline__ int phase_tid(int wave_s) { int lane; asm volatile("v_mbcnt_lo_u32_b32 %0, -1, 0\n\tv_mbcnt_hi_u32_b32 %0, -1, %0" : "=v"(lane)); return wave_s * 64 + lane; }

namespace pg8 {
#define PG8_LAS __attribute__((address_space(3)))
typedef unsigned short bf16_t;
typedef short bf16x8 __attribute__((ext_vector_type(8)));
typedef float f32x4 __attribute__((ext_vector_type(4)));
typedef unsigned u32x4 __attribute__((ext_vector_type(4)));
constexpr int BM = 256, BK = 64, HALF = 128, HTB = HALF * BK * 2  , STAGE_BYTES = 8 * HTB, NXCD = 8, WGM = 8;

__host__ __device__ __forceinline__ int lds_byte(int r, int c) { const int st = (r >> 4) * 2 + (c >> 5), rr = r & 15, cc = c & 31, ob = rr * 64 + cc * 2; return st * 1024 + (ob ^ (((ob >> 9) & 1) << 5)); }
__host__ __device__ __forceinline__ void stage_rc(int b, int& R, int& C) { const int st = b / 1024, sb = b % 1024, swz = sb ^ (((sb >> 9) & 1) << 5); R = (st >> 1) * 16 + swz / 64; C = (st & 1) * 32 + (swz % 64) / 2; }
__host__ __device__ __forceinline__ int perm32(int rho) { const int n = rho >> 4, i = rho & 15; return 8 * (i >> 2) + 4 * n + (i & 3); }

struct Unit { int pm, pn; };
struct Gemm { const bf16_t* A; const bf16_t* Bt; int M, N, K, lda, ldb, kmid; };

struct StaticOrder {
    int nM, nN, nwg, G, c;
    __host__ __device__ void init(int M, int N, int G_, int c_) { nM = M / BM; nN = N / BM; nwg = nM * nN; G = G_; c = c_; }
    __host__ __device__ bool next(int i, Unit& u) const {
        const long L = (long)i * G + c; if (L >= nwg) return false;
        int wgid = (int)L; { const int q = nwg / NXCD, r = nwg % NXCD, xcd = wgid % NXCD, off = wgid / NXCD; wgid = (xcd < r ? xcd * (q + 1) : r * (q + 1) + (xcd - r) * q) + off; }
        const int nig = WGM * nN, gid = wgid / nig, fm = gid * WGM, gsz = (nM - fm) < WGM ? (nM - fm) : WGM;
        u.pm = fm + ((wgid % nig) % gsz); u.pn = (wgid % nig) / gsz; return true;
    }
    __device__ __forceinline__ void a_ready(const Unit&) const {}
    __device__ __forceinline__ void done(const Unit&) const {}
};


template <class Epi, class Sched, bool ALIGN_EPI = false, bool SP2 = false>
__device__ __forceinline__ void gemm_phase(PG8_LAS unsigned char* lds, const Gemm g, const Sched& S, const Epi& E, const int wave_s) {
    int tid_ = phase_tid(wave_s);
    const int tid = tid_, wid = __builtin_amdgcn_readfirstlane(tid >> 6), lane = tid & 63, wr = wid >> 2, wc = wid & 3, fr = lane & 15, fq = lane >> 4;
    const int K = g.K, nt = K / BK;
    unsigned voffA[2], voffB[2];
#pragma unroll
    for (int i = 0; i < 2; ++i) { int R, C; stage_rc(tid * 16 + i * 8192, R, C); const int Rb = Epi::PERM ? ((R & ~31) + perm32(R & 31)) : R;
        voffA[i] = (unsigned)(R * g.lda + C) * 2u; voffB[i] = (unsigned)(Rb * g.ldb + C) * 2u; }
    const size_t kstep = (size_t)(BK * 2);
    const size_t hstepA = (size_t)HALF * g.lda * 2, hstepB = (size_t)HALF * g.ldb * 2;
    const size_t tstepA = 2 * hstepA, tstepB = 2 * hstepB;
    const unsigned ldsw = (unsigned)wid * 1024u;
    const int aoff = lds_byte(wr * 64 + fr, fq * 8), boff = lds_byte(wc * 32 + fr, fq * 8);
#define PG8_SA(b, h) (((b) * 2 + (h)) * HTB)
#define PG8_SB(b, h) ((4 + (b) * 2 + (h)) * HTB)
#define PG8_STAGE(bufoff, gbase, voff) do { _Pragma("unroll") for (int _i = 0; _i < 2; ++_i) \
        __builtin_amdgcn_global_load_lds((const unsigned*)((const char*)(gbase) + (voff)[_i]), (PG8_LAS unsigned*)(lds + (bufoff) + ldsw + _i * 8192), 16, 0, 0); } while (0)
#define PG8_LDA(dst, b, h) do { _Pragma("unroll") for (int m = 0; m < 4; ++m) _Pragma("unroll") for (int k = 0; k < 2; ++k) dst[m][k] = *(const PG8_LAS bf16x8*)(lds + PG8_SA(b, h) + aoff + m * 2048 + k * 1024); } while (0)
#define PG8_LDB(dst, b, h) do { _Pragma("unroll") for (int n = 0; n < 2; ++n) _Pragma("unroll") for (int k = 0; k < 2; ++k) dst[n][k] = *(const PG8_LAS bf16x8*)(lds + PG8_SB(b, h) + boff + n * 2048 + k * 1024); } while (0)
#define PG8_MMA(ai, bj, At, Bt) do { __builtin_amdgcn_s_setprio(1); _Pragma("unroll") for (int m = 0; m < 4; ++m) _Pragma("unroll") for (int n = 0; n < 2; ++n) _Pragma("unroll") for (int k = 0; k < 2; ++k) \
        acc[ai][bj][m][n] = __builtin_amdgcn_mfma_f32_16x16x32_bf16(Bt[n][k], At[m][k], acc[ai][bj][m][n], 0, 0, 0); __builtin_amdgcn_s_setprio(0); } while (0)
#define PG8_WAIT_V(n) asm volatile("s_waitcnt vmcnt(" #n ")" ::: "memory")
#define PG8_WAIT_L(n) asm volatile("s_waitcnt lgkmcnt(" #n ")" ::: "memory")
#define PG8_BAR __builtin_amdgcn_s_barrier()
#define PG8_SCHED __builtin_amdgcn_sched_barrier(0)
    Unit cur, nxt; int ui = 0;
    if (!S.next(0, cur)) return;
    f32x4 acc[2][2][4][2];
#pragma unroll
    for (int a = 0; a < 2; ++a)
#pragma unroll
        for (int b = 0; b < 2; ++b)
#pragma unroll
            for (int m = 0; m < 4; ++m)
#pragma unroll
                for (int n = 0; n < 2; ++n) acc[a][b][m][n] = (f32x4){0.f, 0.f, 0.f, 0.f};
    bf16x8 At[4][2], B0[2][2], B1[2][2];
    const char* cA = (const char*)g.A + (size_t)cur.pm * tstepA; const char* cB = (const char*)g.Bt + (size_t)cur.pn * tstepB;
    S.a_ready(cur);
    if constexpr (SP2) {
        PG8_STAGE(PG8_SB(0, 0), cB, voffB); PG8_STAGE(PG8_SB(0, 1), cB + hstepB, voffB); PG8_STAGE(PG8_SA(0, 0), cA, voffA); PG8_STAGE(PG8_SA(0, 1), cA + hstepA, voffA);
        if (wr == 1) PG8_BAR;
        PG8_WAIT_V(2); PG8_BAR;
        PG8_STAGE(PG8_SB(1, 0), cB + kstep, voffB); PG8_STAGE(PG8_SA(1, 0), cA + kstep, voffA); PG8_STAGE(PG8_SB(1, 1), cB + hstepB + kstep, voffB);
        PG8_WAIT_V(6); PG8_BAR;
    } else {
        PG8_STAGE(PG8_SB(0, 0), cB, voffB); PG8_STAGE(PG8_SA(0, 0), cA, voffA); PG8_STAGE(PG8_SB(0, 1), cB + hstepB, voffB); PG8_STAGE(PG8_SA(0, 1), cA + hstepA, voffA);
        if (wr == 1) PG8_BAR;
        PG8_WAIT_V(4); PG8_BAR;
        PG8_STAGE(PG8_SB(1, 0), cB + kstep, voffB); PG8_STAGE(PG8_SA(1, 0), cA + kstep, voffA); PG8_STAGE(PG8_SB(1, 1), cB + hstepB + kstep, voffB);
        PG8_WAIT_V(6); PG8_BAR;
    }
    for (;;) {
        const bool has_next = S.next(ui + 1, nxt);
        const char* nA = has_next ? (const char*)g.A + (size_t)nxt.pm * tstepA : cA; const char* nB = has_next ? (const char*)g.Bt + (size_t)nxt.pn * tstepB : cB;
        for (int t = 0; t < nt; t += 2) {
            const bool last = (t == nt - 2);
            if constexpr (Epi::HAS_MID) { if (t == g.kmid) { const int lane_e = phase_tid(0), fr_e = lane_e & 15, fq_e = lane_e >> 4; E.mid(acc, cur, wr, wc, fr_e, fq_e); } }
            const char* a1 = cA + (size_t)(t + 1) * kstep;
            const char* a2 = last ? nA : cA + (size_t)(t + 2) * kstep; const char* b2 = last ? nB : cB + (size_t)(t + 2) * kstep;
            const char* a3 = a2 + kstep; const char* b3 = b2 + kstep;
            if (last && has_next) S.a_ready(nxt);
            if constexpr (SP2) {
            PG8_LDB(B0, 0, 0); PG8_LDB(B1, 0, 1); PG8_SCHED; PG8_LDA(At, 0, 0); PG8_STAGE(PG8_SA(1, 1), a1 + hstepA, voffA);
            PG8_WAIT_V(8); PG8_WAIT_L(0); PG8_BAR; PG8_MMA(0, 0, At, B0); PG8_MMA(0, 1, At, B1); PG8_BAR; PG8_SCHED;
            PG8_LDA(At, 0, 1); PG8_STAGE(PG8_SB(0, 0), b2, voffB); PG8_STAGE(PG8_SB(0, 1), b2 + hstepB, voffB); PG8_STAGE(PG8_SA(0, 0), a2, voffA);
            PG8_WAIT_V(8); PG8_WAIT_L(0); PG8_BAR; PG8_MMA(1, 0, At, B0); PG8_MMA(1, 1, At, B1); PG8_BAR; PG8_SCHED;
            PG8_LDB(B0, 1, 0); PG8_LDB(B1, 1, 1); PG8_SCHED; PG8_LDA(At, 1, 0); PG8_STAGE(PG8_SA(0, 1), a2 + hstepA, voffA);
            PG8_WAIT_V(8); PG8_WAIT_L(0); PG8_BAR; PG8_MMA(0, 0, At, B0); PG8_MMA(0, 1, At, B1); PG8_BAR; PG8_SCHED;
            PG8_LDA(At, 1, 1); PG8_STAGE(PG8_SB(1, 0), b3, voffB); PG8_STAGE(PG8_SB(1, 1), b3 + hstepB, voffB); PG8_STAGE(PG8_SA(1, 0), a3, voffA);
            PG8_WAIT_V(8); PG8_WAIT_L(0); PG8_BAR; PG8_MMA(1, 0, At, B0); PG8_MMA(1, 1, At, B1); PG8_BAR; PG8_SCHED;
            } else {
            PG8_LDB(B0, 0, 0); PG8_SCHED; PG8_LDA(At, 0, 0); PG8_STAGE(PG8_SA(1, 1), a1 + hstepA, voffA);
            PG8_WAIT_L(8); PG8_BAR; PG8_WAIT_L(0); PG8_MMA(0, 0, At, B0); PG8_BAR; PG8_SCHED;
            PG8_LDB(B1, 0, 1); PG8_STAGE(PG8_SB(0, 0), b2, voffB);
            PG8_BAR; PG8_WAIT_L(0); PG8_MMA(0, 1, At, B1); PG8_BAR;
            PG8_LDA(At, 0, 1); PG8_STAGE(PG8_SA(0, 0), a2, voffA);
            PG8_BAR; PG8_WAIT_L(0); PG8_MMA(1, 0, At, B0); PG8_BAR; PG8_SCHED;
            PG8_STAGE(PG8_SB(0, 1), b2 + hstepB, voffB);
            PG8_WAIT_V(6); PG8_BAR; PG8_MMA(1, 1, At, B1); PG8_BAR;
            PG8_LDB(B0, 1, 0); PG8_SCHED; PG8_LDA(At, 1, 0); PG8_STAGE(PG8_SA(0, 1), a2 + hstepA, voffA);
            PG8_WAIT_L(8); PG8_BAR; PG8_WAIT_L(0); PG8_MMA(0, 0, At, B0); PG8_BAR; PG8_SCHED;
            PG8_LDB(B1, 1, 1); PG8_STAGE(PG8_SB(1, 0), b3, voffB);
            PG8_BAR; PG8_WAIT_L(0); PG8_MMA(0, 1, At, B1); PG8_BAR;
            PG8_LDA(At, 1, 1); PG8_STAGE(PG8_SA(1, 0), a3, voffA);
            PG8_BAR; PG8_WAIT_L(0); PG8_MMA(1, 0, At, B0); PG8_BAR; PG8_SCHED;
            PG8_STAGE(PG8_SB(1, 1), b3 + hstepB, voffB);
            PG8_WAIT_V(6); PG8_BAR; PG8_MMA(1, 1, At, B1); PG8_BAR;
            }
        }
        if constexpr (ALIGN_EPI) { if (wr == 0) PG8_BAR; }
        if constexpr (!Epi::AFTER_DRAIN) { const int lane_e = phase_tid(0), fr_e = lane_e & 15, fq_e = lane_e >> 4;
            E(acc, cur, wr, wc, fr_e, fq_e); S.done(cur); }
        if (!has_next) break;
#pragma unroll
        for (int a = 0; a < 2; ++a)
#pragma unroll
            for (int b = 0; b < 2; ++b)
#pragma unroll
                for (int m = 0; m < 4; ++m)
#pragma unroll
                    for (int n = 0; n < 2; ++n) acc[a][b][m][n] = (f32x4){0.f, 0.f, 0.f, 0.f};
        cur = nxt; cA = nA; cB = nB; ++ui;
        if constexpr (ALIGN_EPI) { if (wr == 1) PG8_BAR; }
    }
    PG8_WAIT_V(0);
    if constexpr (!ALIGN_EPI) { if (wr == 0) PG8_BAR; }
    PG8_BAR;
    if constexpr (Epi::AFTER_DRAIN) { E.fused(acc, cur, wr, wc, fr, fq, lds, wid, lane); S.done(cur); }
#undef PG8_SA
#undef PG8_SB
#undef PG8_STAGE
#undef PG8_LDA
#undef PG8_LDB
#undef PG8_MMA
#undef PG8_WAIT_V
#undef PG8_WAIT_L
#undef PG8_BAR
#undef PG8_SCHED
}
}


#define LAS __attribute__((address_space(3)))
typedef unsigned short bf16_t;
typedef short bf16x8 __attribute__((ext_vector_type(8)));
typedef float f32x4 __attribute__((ext_vector_type(4)));
typedef float f32x16 __attribute__((ext_vector_type(16)));
typedef unsigned u32x4 __attribute__((ext_vector_type(4)));
typedef unsigned u32x2 __attribute__((ext_vector_type(2)));

constexpr int NB = 8, SEQ = 4096, NMETA = 16, DM = 1024, TREAL = NB * SEQ, TTOT = TREAL + NB * NMETA, MP = 33024, LPOS = SEQ + NMETA;
constexpr int NMAIN = 1792, DFF = 2816, NGU = 2 * DFF, QLORA = 384, KVLORA = 256;
constexpr float EPS = 1e-6f;
constexpr int NTHR = 512, NWAVE = 8;
constexpr int LDS_BYTES = 131072;

constexpr size_t al256(size_t x) { return (x + 255) & ~(size_t)255; }
constexpr size_t WS_ROPE = 0;
constexpr size_t ROPE_BYTES = al256(2ull * LPOS * 16 * 4);
constexpr size_t WS_SS = WS_ROPE + ROPE_BYTES;
constexpr size_t SS_FLOATS = 2ull * 48 * MP;
constexpr size_t WS_HMETA = WS_SS + al256(SS_FLOATS * 4);
constexpr size_t WS_W = WS_HMETA + 256ull * 1024 * 4;
constexpr size_t W_MAIN = 0, W_V = W_MAIN + 1792ull * 1024 * 2, W_UQ = W_V + 512ull * 1024 * 2, W_UK = W_UQ + 768ull * 384 * 2, W_UV = W_UK + 512ull * 256 * 2,
                 W_O = W_UV + 512ull * 256 * 2, W_GU = W_O + 1024ull * 1024 * 2, W_D = W_GU + 5632ull * 1024 * 2, W_LAYER = W_D + 1024ull * 2816 * 2;
constexpr size_t WS_XN = WS_W + 2 * W_LAYER;
constexpr size_t WS_G = WS_XN + (size_t)MP * 1024 * 2;
constexpr size_t G_QK = 0, G_CQ = G_QK + (size_t)MP * 1024 * 2, G_CKV = G_CQ + (size_t)MP * 384 * 2, G_KR = G_CKV + (size_t)MP * 256 * 2, G_VTS = G_KR + (size_t)MP * 32 * 2,
                 G_QM = G_VTS + 512ull * MP * 2, G_KN = G_QM + (size_t)MP * 768 * 2, G_VTM = G_KN + (size_t)MP * 512 * 2, G_O = G_VTM + 512ull * MP * 2, G_END = G_O + (size_t)MP * 1024 * 2;
constexpr size_t G_MIX = 0, G_ACT = 0, G_FFN = G_ACT + (size_t)MP * DFF * 2;
static_assert(G_MIX + (size_t)MP * 1024 * 4 <= G_QM, "mix overlays only dead buffers");
static_assert(G_FFN + (size_t)MP * 1024 * 4 <= G_END, "ffn inside group");
constexpr size_t WS_END = WS_G + G_END;

struct Params {
    const float* in[17];
    float* out; unsigned char* ws;
    float inv_freq[16];
    int ph_lo, ph_hi;
};

typedef __bf16 bf16x2_t __attribute__((ext_vector_type(2)));
typedef float f32x2_t __attribute__((ext_vector_type(2)));
__device__ __forceinline__ unsigned pk_bf16(float lo, float hi) { const f32x2_t v = {lo, hi}; const bf16x2_t b = __builtin_convertvector(v, bf16x2_t); return __builtin_bit_cast(unsigned, b); }
__device__ __forceinline__ float wave_sum(float v) {
#pragma unroll
    for (int o = 1; o < 64; o <<= 1) v += __shfl_xor(v, o);
    return v;
}
__device__ __forceinline__ int row_pos(int row) { return row < TREAL ? NMETA + (row & (SEQ - 1)) : ((row - TREAL) & (NMETA - 1)); }

namespace epi {
using pg8::Unit;
typedef const f32x4 (&AccC)[2][2][4][2];
typedef f32x4 (&AccM)[2][2][4][2];
__device__ __forceinline__ float sum4(const f32x4 a) { return (a[0] + a[1]) + (a[2] + a[3]); }
__device__ __forceinline__ float ss_sum8(const float* p) { return sum4(*(const f32x4*)p) + sum4(*(const f32x4*)(p + 4)); }
__device__ __forceinline__ float ss_sum12(const float* p) { return (sum4(*(const f32x4*)p) + sum4(*(const f32x4*)(p + 4))) + sum4(*(const f32x4*)(p + 8)); }

struct Main {
    static constexpr bool PERM = false, AFTER_DRAIN = false, HAS_MID = false;
    bf16_t *qk, *cq, *ckv, *kr; float* ss_c; const float *cosT, *sinT;
    template <int BJ, int MODE, bool SS>
    __device__ __forceinline__ void half(AccC acc, bf16_t* dst, int ldc, int c0, float* ss, int slot, int rbase, int fq) const {
#pragma unroll
        for (int ai = 0; ai < 2; ++ai)
#pragma unroll
            for (int m = 0; m < 4; ++m) {
                const int row = rbase + ai * 128 + m * 16;
                f32x4 v0 = acc[ai][BJ][m][0], v1 = acc[ai][BJ][m][1];
                if (MODE == 1) {
                    const int pos = row_pos(row);
                    const f32x4 c = *(const f32x4*)(cosT + pos * 16 + 4 * fq), s = *(const f32x4*)(sinT + pos * 16 + 4 * fq);
                    const f32x4 a = v0 * c - v1 * s, b = v1 * c + v0 * s; v0 = a; v1 = b;
                }
                bf16_t* p = dst + (size_t)row * ldc + c0;
                *(u32x2*)p = (u32x2){pk_bf16(v0[0], v0[1]), pk_bf16(v0[2], v0[3])};
                *(u32x2*)(p + 16) = (u32x2){pk_bf16(v1[0], v1[1]), pk_bf16(v1[2], v1[3])};
                if (SS) {
                    float s = (v0[0] * v0[0] + v0[1] * v0[1]) + (v0[2] * v0[2] + v0[3] * v0[3]) + (v1[0] * v1[0] + v1[1] * v1[1]) + (v1[2] * v1[2] + v1[3] * v1[3]);
                    s += __shfl_xor(s, 16); s += __shfl_xor(s, 32);
                    if (fq == 0) ss[(size_t)row * 32 + slot] = s;
                }
            }
    }
    __device__ __forceinline__ void operator()(AccC acc, const Unit& u, int wr, int wc, int fr, int fq) const {
        const int pn = u.pn, rbase = u.pm * 256 + wr * 64 + fr, cb = 32 * wc + 4 * fq;
        if (pn < 4) { half<0, 0, false>(acc, qk, 1024, pn * 256 + cb, nullptr, 0, rbase, fq); half<1, 0, false>(acc, qk, 1024, pn * 256 + 128 + cb, nullptr, 0, rbase, fq); }
        else if (pn == 4) { half<0, 0, true>(acc, cq, 384, cb, ss_c, wc, rbase, fq); half<1, 0, true>(acc, cq, 384, 128 + cb, ss_c, 4 + wc, rbase, fq); }
        else if (pn == 5) { half<0, 0, true>(acc, cq, 384, 256 + cb, ss_c, 8 + wc, rbase, fq); half<1, 0, true>(acc, ckv, 256, cb, ss_c, 16 + wc, rbase, fq); }
        else { half<0, 0, true>(acc, ckv, 256, 128 + cb, ss_c, 20 + wc, rbase, fq); if (wc == 0) half<1, 1, false>(acc, kr, 32, 4 * fq, nullptr, 0, rbase, fq); }
    }
};
struct Bf16R {
    static constexpr bool PERM = false, AFTER_DRAIN = false, HAS_MID = false;
    bf16_t* O; int ldc; const float* ss_row; float invn_row;
    __device__ __forceinline__ void operator()(AccC acc, const Unit& u, int wr, int wc, int fr, int fq) const {
        const int rbase = u.pm * 256 + wr * 64 + fr, cbase = u.pn * 256 + 32 * wc + 4 * fq;
#pragma unroll
        for (int ai = 0; ai < 2; ++ai)
#pragma unroll
            for (int m = 0; m < 4; ++m) {
                const int row = rbase + ai * 128 + m * 16;
                const float rs = ss_row ? __builtin_amdgcn_rsqf(ss_sum8(ss_row + (size_t)row * 32) * invn_row + EPS) : 1.f;
#pragma unroll
                for (int bj = 0; bj < 2; ++bj)
#pragma unroll
                    for (int n = 0; n < 2; ++n) {
                        const f32x4 v = acc[ai][bj][m][n] * rs;
                        *(u32x2*)(O + (size_t)row * ldc + cbase + bj * 128 + n * 16) = (u32x2){pk_bf16(v[0], v[1]), pk_bf16(v[2], v[3])};
                    }
                asm volatile("" ::: "memory");
            }
    }
};
struct Bf16C {
    static constexpr bool PERM = false, AFTER_DRAIN = false, HAS_MID = false;
    bf16_t* O; int ldc; const float* ss_col; float invn_col;
    __device__ __forceinline__ void operator()(AccC acc, const Unit& u, int wr, int wc, int fr, int fq) const {
        const int rbase = u.pm * 256 + wr * 64 + fr, cbase = u.pn * 256 + 32 * wc + 4 * fq;
#pragma unroll
        for (int bj = 0; bj < 2; ++bj)
#pragma unroll
            for (int n = 0; n < 2; ++n) {
                f32x4 cs;
#pragma unroll
                for (int i = 0; i < 4; ++i) cs[i] = __builtin_amdgcn_rsqf(ss_sum8(ss_col + (size_t)(cbase + bj * 128 + n * 16 + i) * 32) * invn_col + EPS);
#pragma unroll
                for (int ai = 0; ai < 2; ++ai)
#pragma unroll
                    for (int m = 0; m < 4; ++m) {
                        const int row = rbase + ai * 128 + m * 16;
                        const f32x4 v = acc[ai][bj][m][n] * cs;
                        *(u32x2*)(O + (size_t)row * ldc + cbase + bj * 128 + n * 16) = (u32x2){pk_bf16(v[0], v[1]), pk_bf16(v[2], v[3])};
                    }
                asm volatile("" ::: "memory");
            }
    }
};
struct QMla {
    static constexpr bool PERM = false, AFTER_DRAIN = false, HAS_MID = false;
    bf16_t* O; const float* ss; const float *cosT, *sinT;
    __device__ __forceinline__ void operator()(AccC acc, const Unit& u, int wr, int wc, int fr, int fq) const {
        const int rbase = u.pm * 256 + wr * 64 + fr;
#pragma unroll
        for (int ai = 0; ai < 2; ++ai)
#pragma unroll
            for (int m = 0; m < 4; ++m) {
                const int row = rbase + ai * 128 + m * 16;
                const float rs = __builtin_amdgcn_rsqf(ss_sum12(ss + (size_t)row * 32) * (1.f / QLORA) + EPS);
                const int pos = row_pos(row);
#pragma unroll
                for (int bj = 0; bj < 2; ++bj) {
                    const int colg = u.pn * 256 + bj * 128 + 32 * wc;
                    f32x4 v0 = acc[ai][bj][m][0] * rs, v1 = acc[ai][bj][m][1] * rs;
                    if (((colg >> 5) % 3) == 2) {
                        const f32x4 c = *(const f32x4*)(cosT + pos * 16 + 4 * fq), s = *(const f32x4*)(sinT + pos * 16 + 4 * fq);
                        const f32x4 a = v0 * c - v1 * s, b = v1 * c + v0 * s; v0 = a; v1 = b;
                    }
                    bf16_t* p = O + (size_t)row * 768 + colg + 4 * fq;
                    *(u32x2*)p = (u32x2){pk_bf16(v0[0], v0[1]), pk_bf16(v0[2], v0[3])};
                    *(u32x2*)(p + 16) = (u32x2){pk_bf16(v1[0], v1[1]), pk_bf16(v1[2], v1[3])};
                }
                asm volatile("" ::: "memory");
            }
    }
};
struct Wo {
    static constexpr bool PERM = false, AFTER_DRAIN = false, HAS_MID = true;
    bf16_t* O; const float* ss_o;
    __device__ __forceinline__ void mid(AccM acc, const Unit& u, int wr, int wc, int fr, int fq) const {
        int rbase = u.pm * 256 + wr * 64 + fr; asm volatile("" : "+v"(rbase) :: "memory");
#pragma unroll
        for (int ai = 0; ai < 2; ++ai)
#pragma unroll
            for (int m = 0; m < 4; ++m) {
                const int row = rbase + ai * 128 + m * 16;
                const float r = __builtin_amdgcn_rsqf(ss_sum8(ss_o + (size_t)row * 16) * (1.f / 512) + EPS) * __builtin_amdgcn_sqrtf(ss_sum8(ss_o + (size_t)row * 16 + 8) * (1.f / 512) + EPS);
#pragma unroll
                for (int bj = 0; bj < 2; ++bj)
#pragma unroll
                    for (int n = 0; n < 2; ++n) acc[ai][bj][m][n] *= r;
            }
    }
    __device__ __forceinline__ void operator()(AccC acc, const Unit& u, int wr, int wc, int fr, int fq) const {
        const int rbase = u.pm * 256 + wr * 64 + fr, cbase = u.pn * 256 + 32 * wc + 4 * fq;
#pragma unroll
        for (int ai = 0; ai < 2; ++ai)
#pragma unroll
            for (int m = 0; m < 4; ++m) {
                const int row = rbase + ai * 128 + m * 16;
                const float r = __builtin_amdgcn_rsqf(ss_sum8(ss_o + (size_t)row * 16 + 8) * (1.f / 512) + EPS);
#pragma unroll
                for (int bj = 0; bj < 2; ++bj)
#pragma unroll
                    for (int n = 0; n < 2; ++n) { const f32x4 v = acc[ai][bj][m][n] * r; *(u32x2*)(O + (size_t)row * 1024 + cbase + bj * 128 + n * 16) = (u32x2){pk_bf16(v[0], v[1]), pk_bf16(v[2], v[3])}; }
            }
    }
};
struct GateUp {
    static constexpr bool PERM = false, AFTER_DRAIN = false, HAS_MID = false;
    bf16_t* O;
    __device__ __forceinline__ void operator()(AccC acc, const Unit& u, int wr, int wc, int fr, int fq) const {
        const int rbase = u.pm * 256 + wr * 64 + fr, cbase = u.pn * 128 + 16 * wc + 4 * fq;
#pragma unroll
        for (int ai = 0; ai < 2; ++ai)
#pragma unroll
            for (int m = 0; m < 4; ++m) {
                const int row = rbase + ai * 128 + m * 16;
#pragma unroll
                for (int bj = 0; bj < 2; ++bj) {
                    const f32x4 g = acc[ai][bj][m][0], up = acc[ai][bj][m][1]; f32x4 a;
#pragma unroll
                    for (int i = 0; i < 4; ++i) a[i] = g[i] * __builtin_amdgcn_rcpf(1.f + __builtin_amdgcn_exp2f(-1.44269504089f * g[i])) * up[i];
                    *(u32x2*)(O + (size_t)row * DFF + cbase + bj * 64) = (u32x2){pk_bf16(a[0], a[1]), pk_bf16(a[2], a[3])};
                }
            }
    }
};
struct F32Out {
    static constexpr bool PERM = false, AFTER_DRAIN = false, HAS_MID = false;
    bf16_t* O;
    __device__ __forceinline__ void operator()(AccC acc, const Unit& u, int wr, int wc, int fr, int fq) const {
        const int rbase = u.pm * 256 + wr * 64 + fr, cbase = u.pn * 256 + 32 * wc + 4 * fq;
#pragma unroll
        for (int ai = 0; ai < 2; ++ai)
#pragma unroll
            for (int m = 0; m < 4; ++m) {
                const int row = rbase + ai * 128 + m * 16;
#pragma unroll
                for (int bj = 0; bj < 2; ++bj)
#pragma unroll
                    for (int n = 0; n < 2; ++n) { const f32x4 v = acc[ai][bj][m][n]; *(u32x2*)(O + (size_t)row * 1024 + cbase + bj * 128 + n * 16) = (u32x2){pk_bf16(v[0], v[1]), pk_bf16(v[2], v[3])}; }
            }
    }
};
}

template <class Epi>
__device__ __forceinline__ void run_gemm(LAS unsigned char* lds, const bf16_t* A, int lda, const bf16_t* Bt, int ldb, int M, int N, int K, int kmid, int rot, const Epi& E, int wave_s) {
    pg8::Gemm g{A, Bt, M, N, K, lda, ldb, kmid};
    int bx = (int)blockIdx.x, G = (int)gridDim.x; asm volatile("" : "+s"(bx), "+s"(G));
    pg8::StaticOrder S; S.init(M, N, G, (bx + G - (rot % G)) % G);
    pg8::gemm_phase<Epi, pg8::StaticOrder, true, true>(lds, g, S, E, wave_s);
}

__device__ __forceinline__ void tr_item(const float* W, int ldw, int scol0, int k0, const float* kg0, const float* kg1, float scale, bf16_t* WT, int K, int drow0, int mode, LAS float* scr, int lane) {
#pragma unroll 8
    for (int i = 0; i < 32; ++i) {
        const int kk = 2 * i + (lane >> 5), k = k0 + kk; float g = scale;
        if (kg0) g *= (kg1 && k >= 512) ? kg1[k - 512] : kg0[k];
        scr[kk * 33 + (lane & 31)] = W[(size_t)k * ldw + scol0 + (lane & 31)] * g;
    }
    asm volatile("s_waitcnt lgkmcnt(0)" ::: "memory");
    const int c = lane & 7;
#pragma unroll
    for (int j = 0; j < 4; ++j) {
        const int n = (lane >> 3) + 8 * j; const LAS float* s = scr + (8 * c) * 33 + n;
        u32x4 o; o.x = pk_bf16(s[0 * 33], s[1 * 33]); o.y = pk_bf16(s[2 * 33], s[3 * 33]); o.z = pk_bf16(s[4 * 33], s[5 * 33]); o.w = pk_bf16(s[6 * 33], s[7 * 33]);
        const int drow = drow0 + (mode ? 32 * (n >> 4) + (n & 15) : n);
        *(u32x4*)(WT + (size_t)drow * K + k0 + 8 * c) = o;
    }
    asm volatile("s_waitcnt lgkmcnt(0)" ::: "memory");
}

constexpr float SCALE_QMLA = 0.10206207261596575f * 1.4426950408889634f;
constexpr int ITEMS_PER_LAYER = 6112;

__device__ __forceinline__ void convert_item(const Params& p, int layer, int it, LAS float* scr, int lane) {
    unsigned char* wl = p.ws + WS_W + (size_t)layer * W_LAYER;
    const float* w_in = p.in[2] + (size_t)layer * 1024 * 2208;
    constexpr int IT_SEG[12] = {0, 256, 512, 768, 1104, 1248, 1312, 1376, 1888, 3296, 4704, 6112};
    int seg = 0;
#pragma unroll
    for (int s = 1; s < 11; ++s) if (it >= IT_SEG[s]) seg = s;
    const int r = it - IT_SEG[seg];
    switch (seg) {
    case 0: { const int nb = r % 16, kb = r / 16; tr_item(w_in, 2208, 32 * nb, 64 * kb, nullptr, nullptr, 0.125f, (bf16_t*)(wl + W_MAIN), 1024, 32 * nb, 0, scr, lane); break; }
    case 1: { const int nb = r % 16, kb = r / 16; tr_item(w_in, 2208, 512 + 32 * nb, 64 * kb, nullptr, nullptr, 1.f, (bf16_t*)(wl + W_MAIN), 1024, 512 + 32 * nb, 0, scr, lane); break; }
    case 2: { const int nb = r % 16, kb = r / 16; tr_item(w_in, 2208, 1024 + 32 * nb, 64 * kb, nullptr, nullptr, 1.f, (bf16_t*)(wl + W_V), 1024, 32 * nb, 0, scr, lane); break; }
    case 3: { const int nb = r % 21, kb = r / 21; tr_item(w_in, 2208, 1536 + 32 * nb, 64 * kb, nullptr, nullptr, 1.f, (bf16_t*)(wl + W_MAIN), 1024, 1024 + 32 * nb, 0, scr, lane); break; }
    case 4: { const int nb = r % 24, kb = r / 24; tr_item(p.in[5] + (size_t)layer * 384 * 768, 768, 32 * nb, 64 * kb, p.in[3] + layer * 384, nullptr, SCALE_QMLA, (bf16_t*)(wl + W_UQ), 384, 32 * nb, 0, scr, lane); break; }
    case 5: { const int nb = r % 16, kb = r / 16; const int n0 = 32 * nb; tr_item(p.in[6] + (size_t)layer * 256 * 1024, 1024, 128 * (n0 >> 6) + (n0 & 63), 64 * kb, p.in[4] + layer * 256, nullptr, 1.f, (bf16_t*)(wl + W_UK), 256, n0, 0, scr, lane); break; }
    case 6: { const int nb = r % 16, kb = r / 16; const int n0 = 32 * nb; tr_item(p.in[6] + (size_t)layer * 256 * 1024, 1024, 128 * (n0 >> 6) + 64 + (n0 & 63), 64 * kb, p.in[4] + layer * 256, nullptr, 1.f, (bf16_t*)(wl + W_UV), 256, n0, 0, scr, lane); break; }
    case 7: { const int nb = r % 32, kb = r / 32; tr_item(p.in[9] + (size_t)layer * 1024 * 1024, 1024, 32 * nb, 64 * kb, p.in[7] + layer * 512, p.in[8] + layer * 512, 1.f, (bf16_t*)(wl + W_O), 1024, 32 * nb, 0, scr, lane); break; }
    case 8: { const int nb = r % 88, kb = r / 88; tr_item(p.in[14] + (size_t)layer * 1024 * DFF, DFF, 32 * nb, 64 * kb, nullptr, nullptr, 1.f, (bf16_t*)(wl + W_GU), 1024, 64 * nb, 1, scr, lane); break; }
    case 9: { const int nb = r % 88, kb = r / 88; tr_item(p.in[15] + (size_t)layer * 1024 * DFF, DFF, 32 * nb, 64 * kb, nullptr, nullptr, 1.f, (bf16_t*)(wl + W_GU), 1024, 64 * nb + 16, 1, scr, lane); break; }
    default: { const int nb = r % 32, kb = r / 32; tr_item(p.in[16] + (size_t)layer * DFF * 1024, 1024, 32 * nb, 64 * kb, nullptr, nullptr, 1.f, (bf16_t*)(wl + W_D), DFF, 32 * nb, 0, scr, lane); break; }
    }
}

__device__ __forceinline__ void sincos_f64(double a, double& s, double& c) {
    const double k = rint(a * 0.63661977236758134308);
    double r = fma(-k, 1.57079632679489655800e+00, a); r = fma(-k, 6.12323399573676603587e-17, r);
    const double r2 = r * r;
    double sp = -1.0 / 1307674368000.0; sp = fma(sp, r2, 1.0 / 6227020800.0); sp = fma(sp, r2, -1.0 / 39916800.0); sp = fma(sp, r2, 1.0 / 362880.0); sp = fma(sp, r2, -1.0 / 5040.0); sp = fma(sp, r2, 1.0 / 120.0); sp = fma(sp, r2, -1.0 / 6.0);
    const double sr = fma(sp * r2, r, r);
    double cp = 1.0 / 20922789888000.0; cp = fma(cp, r2, -1.0 / 87178291200.0); cp = fma(cp, r2, 1.0 / 479001600.0); cp = fma(cp, r2, -1.0 / 3628800.0); cp = fma(cp, r2, 1.0 / 40320.0); cp = fma(cp, r2, -1.0 / 720.0); cp = fma(cp, r2, 1.0 / 24.0); cp = fma(cp, r2, -0.5);
    const double cr = fma(cp, r2, 1.0);
    const int q = ((int)k) & 3;
    s = (q == 0) ? sr : (q == 1) ? cr : (q == 2) ? -sr : -cr;
    c = (q == 0) ? cr : (q == 1) ? -sr : (q == 2) ? -cr : sr;
}

template <int R>
__device__ __forceinline__ void row_step(const bf16_t* const (&y)[R], const float* gy, float* const (&hrow)[R], const float* const (&hsrc)[R], const float* gx, bf16_t* const (&xn)[R], bool has_y, bool has_xn, int lane) {
    f32x4 v[R][4], t[R][4];
#pragma unroll
    for (int r = 0; r < R; ++r)
#pragma unroll
        for (int j = 0; j < 4; ++j) { v[r][j] = *((const f32x4*)hsrc[r] + lane + 64 * j); if (has_y) { const u32x2 w = *((const u32x2*)y[r] + lane + 64 * j); t[r][j] = (f32x4){__uint_as_float(w.x << 16), __uint_as_float(w.x & 0xffff0000u), __uint_as_float(w.y << 16), __uint_as_float(w.y & 0xffff0000u)}; } }
    if (has_y) {
        f32x4 g[4];
#pragma unroll
        for (int j = 0; j < 4; ++j) g[j] = *((const f32x4*)gy + lane + 64 * j);
        float s[R];
#pragma unroll
        for (int r = 0; r < R; ++r) { s[r] = 0.f;
#pragma unroll
            for (int j = 0; j < 4; ++j) s[r] += (t[r][j][0] * t[r][j][0] + t[r][j][1] * t[r][j][1]) + (t[r][j][2] * t[r][j][2] + t[r][j][3] * t[r][j][3]); }
#pragma unroll
        for (int o = 1; o < 64; o <<= 1)
#pragma unroll
            for (int r = 0; r < R; ++r) s[r] += __shfl_xor(s[r], o);
#pragma unroll
        for (int r = 0; r < R; ++r) { const float rs = 1.0f / sqrtf(s[r] * (1.f / DM) + EPS);
#pragma unroll
            for (int j = 0; j < 4; ++j) v[r][j] += t[r][j] * rs * g[j]; }
    }
#pragma unroll
    for (int r = 0; r < R; ++r)
#pragma unroll
        for (int j = 0; j < 4; ++j) *((f32x4*)hrow[r] + lane + 64 * j) = v[r][j];
    if (has_xn) {
        f32x4 g[4];
#pragma unroll
        for (int j = 0; j < 4; ++j) g[j] = *((const f32x4*)gx + lane + 64 * j);
        float s[R];
#pragma unroll
        for (int r = 0; r < R; ++r) { s[r] = 0.f;
#pragma unroll
            for (int j = 0; j < 4; ++j) s[r] += (v[r][j][0] * v[r][j][0] + v[r][j][1] * v[r][j][1]) + (v[r][j][2] * v[r][j][2] + v[r][j][3] * v[r][j][3]); }
#pragma unroll
        for (int o = 1; o < 64; o <<= 1)
#pragma unroll
            for (int r = 0; r < R; ++r) s[r] += __shfl_xor(s[r], o);
#pragma unroll
        for (int r = 0; r < R; ++r) { const float rs = 1.0f / sqrtf(s[r] * (1.f / DM) + EPS);
#pragma unroll
            for (int j = 0; j < 4; ++j) { const f32x4 o = v[r][j] * rs * g[j]; *((u32x2*)xn[r] + lane + 64 * j) = (u32x2){pk_bf16(o[0], o[1]), pk_bf16(o[2], o[3])}; } }
    }
}
__device__ __forceinline__ float* h_row(const Params& p, int row) { return row < TREAL ? p.out + (size_t)row * DM : (float*)(p.ws + WS_HMETA) + (size_t)(row - TREAL) * DM; }

__device__ __forceinline__ void phase_prologue(const Params& p, LAS unsigned char* lds, int wave_s) {
    int tid_ = phase_tid(wave_s);
    const int tid = tid_, lane = tid & 63, wave = tid >> 6, G = gridDim.x;
    const int gt = blockIdx.x * NTHR + tid, NGT = G * NTHR, gw = blockIdx.x * NWAVE + wave, NGW = G * NWAVE;
    float* cosT = (float*)(p.ws + WS_ROPE); float* sinT = cosT + LPOS * 16;
    for (int i = gt; i < LPOS * 16; i += NGT) { const int pos = i >> 4, j = i & 15; const float ang = (float)pos * p.inv_freq[j]; double s, c; sincos_f64((double)ang, s, c); cosT[i] = (float)c; sinT[i] = (float)s; }
    for (int l = 0; l < 2; ++l) {
        u32x4* z = (u32x4*)(p.ws + WS_W + (size_t)l * W_LAYER + W_MAIN + 1696ull * 1024 * 2);
        for (int i = gt; i < 96 * 1024 * 2 / 16; i += NGT) z[i] = (u32x4){0u, 0u, 0u, 0u};
    }
    LAS float* scr = (LAS float*)(lds + wave * 16384);
    for (int it = gw; it < 2 * ITEMS_PER_LAYER; it += NGW) { const int layer = it >= ITEMS_PER_LAYER ? 1 : 0; convert_item(p, layer, it - layer * ITEMS_PER_LAYER, scr, lane); }
    bf16_t* xn = (bf16_t*)(p.ws + WS_XN);
    constexpr int RR = 4;
    for (int row0 = gw * RR; row0 < TTOT; row0 += NGW * RR) {
        const float* src[RR]; float* hr[RR]; bf16_t* xr[RR]; const bf16_t* yy[RR];
#pragma unroll
        for (int r = 0; r < RR; ++r) { const int row = row0 + r; src[r] = row < TREAL ? p.in[0] + (size_t)row * DM : p.in[1] + (size_t)((row - TREAL) & 15) * DM; hr[r] = h_row(p, row); xr[r] = xn + (size_t)row * DM; yy[r] = nullptr; }
        row_step<RR>(yy, nullptr, hr, src, p.in[10], xr, false, true, lane);
    }
}
__device__ __forceinline__ void phase_rows(const Params& p, const bf16_t* y, const float* gy, const float* gx, bool make_xn, int nrows, int wave_s) {
    int tid_ = phase_tid(wave_s);
    const int tid = tid_, lane = tid & 63, wave = tid >> 6, gw = blockIdx.x * NWAVE + wave, NGW = gridDim.x * NWAVE;
    bf16_t* xn = (bf16_t*)(p.ws + WS_XN);
    constexpr int RR = 4;
    for (int row0 = gw * RR; row0 < nrows; row0 += NGW * RR) {
        const float* src[RR]; float* hr[RR]; bf16_t* xr[RR]; const bf16_t* yy[RR];
#pragma unroll
        for (int r = 0; r < RR; ++r) { const int row = row0 + r; hr[r] = h_row(p, row); src[r] = hr[r]; xr[r] = xn + (size_t)row * DM; yy[r] = y + (size_t)row * DM; }
        row_step<RR>(yy, gy, hr, src, gx, xr, true, make_xn, lane);
    }
}

namespace att {
constexpr int KS_SB = 144, KS_ML = 208, VS = 144;
constexpr int KB0 = 0, KBSZ = 64 * KS_ML, VB0 = 2 * KBSZ, VBSZ = 64 * VS, FLG = VB0 + 2 * VBSZ;
__device__ __forceinline__ int pi_row(int m) { return 16 * (m >> 4) + 8 * ((m >> 2) & 1) + 4 * ((m >> 3) & 1) + (m & 3); }
#define MFMA32(a, b, c) __builtin_amdgcn_mfma_f32_32x32x16_bf16(a, b, c, 0, 0, 0)
__device__ __forceinline__ bf16x8 pack8(const f32x16& s, int o) {
    u32x4 w; w.x = pk_bf16(s[o + 0], s[o + 1]); w.y = pk_bf16(s[o + 2], s[o + 3]); w.z = pk_bf16(s[o + 4], s[o + 5]); w.w = pk_bf16(s[o + 6], s[o + 7]);
    return __builtin_bit_cast(bf16x8, w);
}
__device__ __forceinline__ void store_o(const f32x16& o0, const f32x16& o1, float inv, bf16_t* orow, float* ssrow, int hi, bool valid) {
    float ssq = 0.f;
#pragma unroll
    for (int db = 0; db < 2; ++db)
#pragma unroll
        for (int a = 0; a < 4; ++a) {
            const f32x16& o = db ? o1 : o0;
            const float v0 = o[4 * a] * inv, v1 = o[4 * a + 1] * inv, v2 = o[4 * a + 2] * inv, v3 = o[4 * a + 3] * inv;
            ssq += (v0 * v0 + v1 * v1) + (v2 * v2 + v3 * v3);
            if (valid) *(u32x2*)(orow + 32 * db + 8 * a + 4 * hi) = (u32x2){pk_bf16(v0, v1), pk_bf16(v2, v3)};
        }
    ssq += __shfl_xor(ssq, 32);
    if (valid && hi == 0) *ssrow = ssq;
}

__device__ __forceinline__ void mla_unit(int wave_s, LAS unsigned char* lds, const bf16_t* Q, const bf16_t* Kn, const bf16_t* Kr, const bf16_t* VT, bf16_t* O, float* ss, int b, int h, int qb) {
    int tid_ = phase_tid(wave_s);
    const int tid = tid_, lane = tid & 63, w = __builtin_amdgcn_readfirstlane(tid >> 6), ql = lane & 31, hi = lane >> 5;
    const bool meta = qb < 0;
    const int qrow = meta ? (TREAL + b * 16 + (ql & 15)) : (b * SEQ + qb * 256 + w * 32 + ql);
    const int qt = meta ? ql : (qb * 256 + w * 32 + ql);
    bf16x8 qf[6];
#pragma unroll
    for (int ks = 0; ks < 6; ++ks) qf[ks] = *(const bf16x8*)(Q + (size_t)qrow * 768 + h * 96 + (2 * ks + hi) * 8);
    const int ntiles = meta ? 1 : 4 * qb + 5;
    const int wlast = meta ? (w == 0 ? 0 : -1) : 1 + 4 * qb + (w >> 1);
    const int krow = tid >> 3, kch = tid & 7, rrow = tid >> 2, rch = tid & 3;
    const unsigned aoff = (unsigned)(pi_row(ql) * KS_ML + hi * 16), voff = (unsigned)(ql * VS + hi * 16);
    float mrun = -INFINITY, lrun = 0.f;
    f32x16 o0, o1;
#pragma unroll
    for (int i = 0; i < 16; ++i) { o0[i] = 0.f; o1[i] = 0.f; }
    struct TR { u32x4 k, r, v; };
    TR RA, RB; RA.r = (u32x4){0u, 0u, 0u, 0u}; RB.r = RA.r;
    auto gload = [&](TR& t, int i) {
        const int row0 = (i == 0) ? TREAL + b * 16 : b * SEQ + 64 * (i - 1);
        t.k = *(const u32x4*)(Kn + (size_t)(row0 + krow) * 512 + h * 64 + kch * 8);
        if (tid < 256) t.r = *(const u32x4*)(Kr + (size_t)(row0 + rrow) * 32 + rch * 8);
        t.v = *(const u32x4*)(VT + (size_t)(h * 64 + krow) * MP + row0 + kch * 8);
    };
    auto lstore = [&](const TR& t, int buf) {
        *(LAS u32x4*)(lds + KB0 + buf * KBSZ + krow * KS_ML + kch * 16) = t.k;
        if (tid < 256) *(LAS u32x4*)(lds + KB0 + buf * KBSZ + rrow * KS_ML + 128 + rch * 16) = t.r;
        *(LAS u32x4*)(lds + VB0 + buf * VBSZ + krow * VS + kch * 16) = t.v;
    };
    auto step = [&](int i, TR& X, TR& Y) {
        const int buf = i & 1;
        if (i + 2 < ntiles) gload(Y, i + 2);
        if (i <= wlast) {
            const LAS unsigned char* kb = lds + KB0 + buf * KBSZ + aoff; const LAS unsigned char* vb = lds + VB0 + buf * VBSZ + voff;
            f32x16 s0, s1;
#pragma unroll
            for (int r = 0; r < 16; ++r) { s0[r] = 0.f; s1[r] = 0.f; }
#pragma unroll
            for (int ks = 0; ks < 6; ++ks) {
                const bf16x8 a0 = *(const LAS bf16x8*)(kb + ks * 32), a1 = *(const LAS bf16x8*)(kb + 32 * KS_ML + ks * 32);
                s0 = MFMA32(a0, qf[ks], s0); s1 = MFMA32(a1, qf[ks], s1);
            }
            const int lim = (i == 0) ? (meta ? (ql < 15 ? ql : 15) : 15) : qt - 64 * (i - 1);
            if (__ballot(lim < 63) != 0ull) {
#pragma unroll
                for (int r = 0; r < 16; ++r) { const int ki = 16 * (r >> 3) + 8 * hi + (r & 7); if (ki > lim) s0[r] = -INFINITY; if (ki + 32 > lim) s1[r] = -INFINITY; }
            }
            float mx = fmaxf(s0[0], s1[0]);
#pragma unroll
            for (int r = 1; r < 16; ++r) mx = fmaxf(mx, fmaxf(s0[r], s1[r]));
            mx = fmaxf(mx, __shfl_xor(mx, 32));
            const float mn = fmaxf(mrun, mx);
            if (__ballot(mn > mrun) != 0ull) {
                const float alpha = __builtin_amdgcn_exp2f(mrun - mn); lrun *= alpha;
#pragma unroll
                for (int r = 0; r < 16; ++r) { o0[r] *= alpha; o1[r] *= alpha; }
            }
            mrun = mn;
            float rs = 0.f;
#pragma unroll
            for (int r = 0; r < 16; ++r) { s0[r] = __builtin_amdgcn_exp2f(s0[r] - mn); s1[r] = __builtin_amdgcn_exp2f(s1[r] - mn); rs += s0[r] + s1[r]; }
            lrun += rs;
#pragma unroll
            for (int s = 0; s < 4; ++s) {
                const bf16x8 pf = pack8((s >> 1) ? s1 : s0, 8 * (s & 1));
                const bf16x8 v0 = *(const LAS bf16x8*)(vb + s * 32), v1 = *(const LAS bf16x8*)(vb + 32 * VS + s * 32);
                o0 = MFMA32(v0, pf, o0); o1 = MFMA32(v1, pf, o1);
            }
        }
        if (i + 1 < ntiles) lstore(X, buf ^ 1);
        __syncthreads();
    };
    gload(RB, 0); lstore(RB, 0); if (ntiles > 1) gload(RA, 1); __syncthreads();
    for (int i = 0; i < ntiles; i += 2) { step(i, RA, RB); if (i + 1 < ntiles) step(i + 1, RB, RA); }
    lrun += __shfl_xor(lrun, 32);
    const bool valid = meta ? (w == 0 && ql < 16) : true;
    store_o(o0, o1, 1.0f / lrun, O + (size_t)qrow * 1024 + 512 + h * 64, ss + (size_t)qrow * 16 + 8 + h, hi, valid);
}

__device__ __forceinline__ void sb_unit(int wave_s, LAS unsigned char* lds, const bf16_t* QK, const bf16_t* VT, bf16_t* O, float* ss, int b, int h, int qb) {
    int tid_ = phase_tid(wave_s);
    const int tid = tid_, lane = tid & 63, w = __builtin_amdgcn_readfirstlane(tid >> 6), ql = lane & 31, hi = lane >> 5;
    const bool meta = qb < 0;
    const int qrow = meta ? (TREAL + b * 16 + (ql & 15)) : (b * SEQ + qb * 256 + w * 32 + ql);
    const int qt = meta ? ql : (qb * 256 + w * 32 + ql);
    bf16x8 qf[4];
#pragma unroll
    for (int ks = 0; ks < 4; ++ks) qf[ks] = *(const bf16x8*)(QK + (size_t)qrow * 1024 + h * 64 + (2 * ks + hi) * 8);
    const int ntiles = meta ? 1 : 4 * qb + 5;
    const int wfirst = meta ? (w == 0 ? 0 : 1) : 3 - (w >> 1);
    const int krow = tid >> 3, kch = tid & 7;
    const unsigned aoff = (unsigned)(pi_row(ql) * KS_SB + hi * 16), voff = (unsigned)(ql * VS + hi * 16);
    f32x16 o0, o1;
#pragma unroll
    for (int i = 0; i < 16; ++i) { o0[i] = 0.f; o1[i] = 0.f; }
    float carry = 0.f;
    struct TR { u32x4 k, v; };
    TR RA, RB;
    auto gload = [&](TR& t, int i) {
        const int row0 = (meta || i == ntiles - 1) ? TREAL + b * 16 : b * SEQ + 64 * (4 * qb + 3 - i);
        t.k = *(const u32x4*)(QK + (size_t)(row0 + krow) * 1024 + 512 + h * 64 + kch * 8);
        t.v = *(const u32x4*)(VT + (size_t)(h * 64 + krow) * MP + row0 + kch * 8);
    };
    auto lstore = [&](const TR& t, int buf) {
        *(LAS u32x4*)(lds + KB0 + buf * KBSZ + krow * KS_SB + kch * 16) = t.k;
        *(LAS u32x4*)(lds + VB0 + buf * VBSZ + krow * VS + kch * 16) = t.v;
    };
    LAS int* flg = (LAS int*)(lds + FLG);
    auto step = [&](int i, TR& X, TR& Y) -> bool {
        const int buf = i & 1;
        if (i > 0) {
            int all = 1;
#pragma unroll
            for (int k = 0; k < NWAVE; ++k) all &= flg[(buf ^ 1) * NWAVE + k];
            if (all) return true;
        }
        if (i + 2 < ntiles) gload(Y, i + 2);
        if (i >= wfirst) {
            const LAS unsigned char* kb = lds + KB0 + buf * KBSZ + aoff; const LAS unsigned char* vb = lds + VB0 + buf * VBSZ + voff;
            f32x16 s0, s1, l0, l1;
#pragma unroll
            for (int r = 0; r < 16; ++r) { s0[r] = 0.f; s1[r] = 0.f; }
#pragma unroll
            for (int ks = 0; ks < 4; ++ks) {
                const bf16x8 a0 = *(const LAS bf16x8*)(kb + ks * 32), a1 = *(const LAS bf16x8*)(kb + 32 * KS_SB + ks * 32);
                s0 = MFMA32(a0, qf[ks], s0); s1 = MFMA32(a1, qf[ks], s1);
            }
            const bool mtile = meta || i == ntiles - 1;
            const int lim = mtile ? (meta ? (ql < 16 ? ql - 1 : 15) : 15) : qt - 64 * (4 * qb + 3 - i) - 1;
#pragma unroll
            for (int r = 0; r < 16; ++r) {
                const int ki = 16 * (r >> 3) + 8 * hi + (r & 7);
                { const float z = s0[r], sp = fmaxf(z, 0.f) + 0.69314718056f * __builtin_amdgcn_logf(1.f + __builtin_amdgcn_exp2f(-1.44269504089f * fabsf(z))); const bool ok = ki <= lim; l0[r] = ok ? -sp : 0.f; s0[r] = ok ? z : -INFINITY; }
                { const float z = s1[r], sp = fmaxf(z, 0.f) + 0.69314718056f * __builtin_amdgcn_logf(1.f + __builtin_amdgcn_exp2f(-1.44269504089f * fabsf(z))); const bool ok = ki + 32 <= lim; l1[r] = ok ? -sp : 0.f; s1[r] = ok ? z : -INFINITY; }
            }
            float og[4], pg[4];
#pragma unroll
            for (int q = 0; q < 4; ++q) { const f32x16& l = (q >> 1) ? l1 : l0; const int o = 8 * (q & 1);
                og[q] = ((l[o] + l[o + 1]) + (l[o + 2] + l[o + 3])) + ((l[o + 4] + l[o + 5]) + (l[o + 6] + l[o + 7])); pg[q] = __shfl_xor(og[q], 32); }
            float tail = carry;
#pragma unroll
            for (int q = 3; q >= 0; --q) {
                f32x16& l = (q >> 1) ? l1 : l0; f32x16& s = (q >> 1) ? s1 : s0; const int o = 8 * (q & 1);
                float run = tail + (hi == 0 ? pg[q] : 0.f);
#pragma unroll
                for (int j = 7; j >= 0; --j) { const float lm = l[o + j]; s[o + j] = __builtin_amdgcn_exp2f(1.44269504089f * (s[o + j] + lm + run)); run += lm; }
                tail += og[q] + pg[q];
            }
            carry = tail;
#pragma unroll
            for (int s = 0; s < 4; ++s) {
                const bf16x8 pf = pack8((s >> 1) ? s1 : s0, 8 * (s & 1));
                const bf16x8 v0 = *(const LAS bf16x8*)(vb + s * 32), v1 = *(const LAS bf16x8*)(vb + 32 * VS + s * 32);
                o0 = MFMA32(v0, pf, o0); o1 = MFMA32(v1, pf, o1);
            }
        }
        { const int dn = (__ballot(carry >= -104.0f) == 0ull) ? 1 : 0; if (lane == 0) flg[buf * NWAVE + w] = dn; }
        if (i + 1 < ntiles) lstore(X, buf ^ 1);
        __syncthreads();
        return false;
    };
    gload(RB, 0); lstore(RB, 0); if (ntiles > 1) gload(RA, 1); __syncthreads();
    for (int i = 0; i < ntiles; i += 2) { if (step(i, RA, RB)) break; if (i + 1 < ntiles) { if (step(i + 1, RB, RA)) break; } }
    __syncthreads();
    const bool valid = meta ? (w == 0 && ql < 16) : true;
    store_o(o0, o1, 1.0f, O + (size_t)qrow * 1024 + h * 64, ss + (size_t)qrow * 16 + h, hi, valid);
}

__device__ __forceinline__ void phase_attention(const Params& p, LAS unsigned char* lds, int layer, int wave_s) {
    unsigned char* g = p.ws + WS_G;
    const bf16_t* QK = (const bf16_t*)(g + G_QK); const bf16_t* VTS = (const bf16_t*)(g + G_VTS);
    const bf16_t* QM = (const bf16_t*)(g + G_QM); const bf16_t* KN = (const bf16_t*)(g + G_KN); const bf16_t* KR = (const bf16_t*)(g + G_KR); const bf16_t* VTM = (const bf16_t*)(g + G_VTM);
    bf16_t* O = (bf16_t*)(g + G_O);
    float* ss_sb = (float*)(p.ws + WS_SS) + (size_t)layer * 48 * MP + (size_t)32 * MP; float* ss_ml = ss_sb;
    const int nunits = layer == 1 ? 2048 : 2176;
    for (int idx = blockIdx.x; idx < nunits; idx += gridDim.x) {
        if (idx < 1024) {
            const int rnd = idx >> 8, cc = idx & 255, grp = cc >> 6, bh = cc & 63;
            const int qb = rnd == 0 ? 15 - grp : rnd == 1 ? 8 + grp : rnd == 2 ? 7 - grp : grp;
            mla_unit(wave_s, lds, QM, KN, KR, VTM, O, ss_ml, bh >> 3, bh & 7, qb);
        } else if (idx < 2048) {
            const int k = idx - 1024, bh = k & 63, qb = k >> 6;
            sb_unit(wave_s, lds, QK, VTS, O, ss_sb, bh >> 3, bh & 7, qb);
        } else if (idx < 2112) { const int bh = idx - 2048; mla_unit(wave_s, lds, QM, KN, KR, VTM, O, ss_ml, bh >> 3, bh & 7, -1); }
        else { const int bh = idx - 2112; sb_unit(wave_s, lds, QK, VTS, O, ss_sb, bh >> 3, bh & 7, -1); }
    }
}
}


__device__ __forceinline__ void grid_barrier(unsigned* cnt, unsigned target) {
    asm volatile("s_waitcnt vmcnt(0) lgkmcnt(0)" ::: "memory");
    __syncthreads();
    if (threadIdx.x == 0) {
        __builtin_amdgcn_fence(__ATOMIC_RELEASE, "agent");
        asm volatile("s_waitcnt vmcnt(0)" ::: "memory");
        __hip_atomic_fetch_add(cnt, 1u, __ATOMIC_RELAXED, __HIP_MEMORY_SCOPE_AGENT);
        while (__hip_atomic_load(cnt, __ATOMIC_RELAXED, __HIP_MEMORY_SCOPE_AGENT) < target) __builtin_amdgcn_s_sleep(1);
        __builtin_amdgcn_fence(__ATOMIC_ACQUIRE, "agent");
        asm volatile("s_waitcnt vmcnt(0)" ::: "memory");
    }
    __syncthreads();
}

__global__ void __launch_bounds__(NTHR) hybrid_fwd(Params p) {
    extern __shared__ __attribute__((aligned(16))) unsigned char smem[];
    LAS unsigned char* lds = (LAS unsigned char*)smem;
    cg::grid_group grid = cg::this_grid();
    const int wave_s = __builtin_amdgcn_readfirstlane((int)threadIdx.x >> 6);
    unsigned char* ws = p.ws; unsigned char* g = ws + WS_G;
    const float* cosT = (const float*)(ws + WS_ROPE); const float* sinT = cosT + LPOS * 16;
    bf16_t* xn = (bf16_t*)(ws + WS_XN);
    const int lo = p.ph_lo, hi = p.ph_hi;
    int ph = 0, nbar = 0;
    unsigned* bar_cnt = (unsigned*)(ws + WS_HMETA + 200ull * 1024 * 4);
    if (blockIdx.x == 0 && threadIdx.x == 0) __hip_atomic_store(bar_cnt, 0u, __ATOMIC_RELAXED, __HIP_MEMORY_SCOPE_AGENT);
#ifndef PHMASK
#define PHMASK 0xFFFFFFFFu
#endif
#define PHASE_BEGIN if (ph >= lo && ph < hi) {
#define PHASE_END   if (ph + 1 < hi) { if (ph == lo) grid.sync(); else grid_barrier(bar_cnt, (unsigned)(++nbar) * gridDim.x); } } ++ph;

    PHASE_BEGIN if (PHMASK & 1u) phase_prologue(p, lds, wave_s); PHASE_END
    for (int layer = 0; layer < 2; ++layer) {
        unsigned char* wl = ws + WS_W + (size_t)layer * W_LAYER;
        float* ss_c = (float*)(ws + WS_SS) + (size_t)layer * 48 * MP; float* ss_o = ss_c + (size_t)32 * MP;
        const int Mrows = layer == 1 ? TREAL : MP, nrows = layer == 1 ? TREAL : TTOT;
        PHASE_BEGIN if (PHMASK & 2u) {
            epi::Main E{(bf16_t*)(g + G_QK), (bf16_t*)(g + G_CQ), (bf16_t*)(g + G_CKV), (bf16_t*)(g + G_KR), ss_c, cosT, sinT};
#ifndef NO_A
            run_gemm(lds, xn, 1024, (const bf16_t*)(wl + W_MAIN), 1024, MP, NMAIN, 1024, -1, 0, E, wave_s);
#endif
            epi::Bf16R EV{(bf16_t*)(g + G_VTS), MP, nullptr, 0.f};
#ifndef NO_B
            run_gemm(lds, (const bf16_t*)(wl + W_V), 1024, xn, 1024, 512, MP, 1024, -1, 136, EV, wave_s);
#endif
 }
        PHASE_END
        PHASE_BEGIN if (PHMASK & 4u) {
            epi::QMla EQ{(bf16_t*)(g + G_QM), ss_c, cosT, sinT};
#ifndef NO_A
            run_gemm(lds, (const bf16_t*)(g + G_CQ), 384, (const bf16_t*)(wl + W_UQ), 384, MP, 768, 384, -1, 0, EQ, wave_s);
#endif
            epi::Bf16R EK{(bf16_t*)(g + G_KN), 512, ss_c + 16, 1.f / KVLORA};
#ifndef NO_B
            run_gemm(lds, (const bf16_t*)(g + G_CKV), 256, (const bf16_t*)(wl + W_UK), 256, MP, 512, 256, -1, 128, EK, wave_s);
#endif
            epi::Bf16C EV{(bf16_t*)(g + G_VTM), MP, ss_c + 16, 1.f / KVLORA};
#ifndef NO_C
            run_gemm(lds, (const bf16_t*)(wl + W_UV), 256, (const bf16_t*)(g + G_CKV), 256, 512, MP, 256, -1, 136, EV, wave_s);
#endif
 }
        PHASE_END
        PHASE_BEGIN if (PHMASK & 8u) att::phase_attention(p, lds, layer, wave_s); PHASE_END
        PHASE_BEGIN if (PHMASK & 16u) {
            epi::Wo E{(bf16_t*)(g + G_MIX), ss_o};
            run_gemm(lds, (const bf16_t*)(g + G_O), 1024, (const bf16_t*)(wl + W_O), 1024, Mrows, 1024, 1024, 8, 0, E, wave_s); }
        PHASE_END
        PHASE_BEGIN if (PHMASK & 32u) phase_rows(p, (const bf16_t*)(g + G_MIX), p.in[11] + layer * DM, p.in[12] + layer * DM, true, nrows, wave_s); PHASE_END
        PHASE_BEGIN if (PHMASK & 64u) {
            epi::GateUp E{(bf16_t*)(g + G_ACT)};
            run_gemm(lds, xn, 1024, (const bf16_t*)(wl + W_GU), 1024, Mrows, NGU, 1024, -1, 0, E, wave_s); }
        PHASE_END
        PHASE_BEGIN if (PHMASK & 128u) {
            epi::F32Out E{(bf16_t*)(g + G_FFN)};
            run_gemm(lds, (const bf16_t*)(g + G_ACT), DFF, (const bf16_t*)(wl + W_D), DFF, Mrows, 1024, DFF, -1, 0, E, wave_s); }
        PHASE_END
        PHASE_BEGIN if (PHMASK & 256u) phase_rows(p, (const bf16_t*)(g + G_FFN), p.in[13] + layer * DM, p.in[10] + (layer < 1 ? (layer + 1) * DM : 0), layer < 1, nrows, wave_s); PHASE_END
    }
}
constexpr int N_PHASES = 17;

#ifdef DBG_STOP
__global__ void __launch_bounds__(256) dbg_dump(Params p) {
    unsigned char* g = p.ws + WS_G;
    const size_t n = (size_t)TREAL * DM;
    for (size_t i = (size_t)blockIdx.x * 256 + threadIdx.x; i < n; i += (size_t)gridDim.x * 256) {
        const size_t row = i >> 10, c = i & 1023; float v = 0.f;
        auto bf = [](const unsigned char* b, size_t idx) { return __uint_as_float((unsigned)((const bf16_t*)b)[idx] << 16); };
#if DBG_DUMP == 1
        v = bf(g + G_QK, row * 1024 + c) + bf(g + G_CQ, row * 384 + c % 384) + bf(g + G_CKV, row * 256 + c % 256) + bf(g + G_KR, row * 32 + c % 32) + bf(g + G_VTS, (c % 512) * MP + row)
          + ((const float*)(p.ws + WS_SS))[row] + ((const float*)(p.ws + WS_SS))[MP + row];
#elif DBG_DUMP == 2
        v = bf(g + G_QM, row * 768 + c % 768) + bf(g + G_KN, row * 512 + c % 512) + bf(g + G_VTM, (c % 512) * MP + row);
#elif DBG_DUMP == 3
        v = bf(g + G_O, row * 1024 + c);
#elif DBG_DUMP == 31
        v = c < 512 ? bf(g + G_O, row * 1024 + c) : 0.f;
#elif DBG_DUMP == 32
        v = c >= 512 ? bf(g + G_O, row * 1024 + c) : 0.f;
#elif DBG_DUMP == 4
        v = ((const float*)(g + G_MIX))[row * 1024 + c];
#elif DBG_DUMP == 5
        v = bf(p.ws + WS_XN, row * 1024 + c);
#elif DBG_DUMP == 6
        v = bf(g + G_ACT, row * DFF + c) + bf(g + G_ACT, row * DFF + 1024 + c) + bf(g + G_ACT, row * DFF + 1792 + c);
#elif DBG_DUMP == 7
        v = ((const float*)(g + G_FFN))[row * 1024 + c];
#endif
#ifdef DBG_SAN
        if (!(fabsf(v) < 1e30f)) v = 12345.f;
#endif
        p.out[i] = v;
    }
}
#endif

extern "C" void kernel_launch(void* const* d_in, const int* in_sizes, int n_in, void* d_out, int out_size, void* d_ws, size_t ws_size, hipStream_t stream) {
    static int grid = 0;
    if (grid == 0) {
        if (n_in != 17 || ws_size < WS_END) { fprintf(stderr, "kernel_launch: need 17 inputs and %zu bytes of workspace (got %d, %zu)\n", (size_t)WS_END, n_in, ws_size); grid = -1; return; }
        int dev = 0, cus = 0, per_cu = 0;
        (void)hipGetDevice(&dev); (void)hipDeviceGetAttribute(&cus, hipDeviceAttributeMultiprocessorCount, dev);
        (void)hipFuncSetAttribute((const void*)hybrid_fwd, hipFuncAttributeMaxDynamicSharedMemorySize, LDS_BYTES);
        (void)hipOccupancyMaxActiveBlocksPerMultiprocessor(&per_cu, (const void*)hybrid_fwd, NTHR, LDS_BYTES);
        if (per_cu < 1) { fprintf(stderr, "kernel_launch: occupancy query says %d blocks per CU\n", per_cu); per_cu = 1; }
        (void)hipGetLastError();
        grid = cus * 1;
    }
    if (grid < 0) return;
    Params p; memset(&p, 0, sizeof(p));
    for (int i = 0; i < 17; ++i) p.in[i] = (const float*)d_in[i];
    p.out = (float*)d_out; p.ws = (unsigned char*)d_ws;
    for (int i = 0; i < 16; ++i) p.inv_freq[i] = 1.0f / powf(10000.0f, (float)(2 * i) / 32.0f);
#ifndef MK_LAUNCHES
#define MK_LAUNCHES 1
#endif
    if (MK_LAUNCHES == 1) {
        p.ph_lo = 0; p.ph_hi = N_PHASES;
        void* args[] = {&p};
        hipError_t e = hipLaunchCooperativeKernel((const void*)hybrid_fwd, dim3(grid), dim3(NTHR), args, LDS_BYTES, stream);
        if (e != hipSuccess) fprintf(stderr, "cooperative launch failed: %s (grid %d)\n", hipGetErrorString(e), grid);
    } else {
#ifdef DBG_STOP
        for (int k = 0; k < DBG_STOP; ++k) { p.ph_lo = k; p.ph_hi = k + 1; hipLaunchKernelGGL(hybrid_fwd, dim3(grid), dim3(NTHR), LDS_BYTES, stream, p); }
        hipLaunchKernelGGL(dbg_dump, dim3(2048), dim3(256), 0, stream, p);
#else
        for (int k = 0; k < N_PHASES; ++k) { p.ph_lo = k; p.ph_hi = k + 1; hipLaunchKernelGGL(hybrid_fwd, dim3(grid), dim3(NTHR), LDS_BYTES, stream, p); }
#endif
    }
}
```

```cpp
#include <hip/hip_runtime.h>
#include <hip/hip_cooperative_groups.h>
#include <cstdio>
#include <cstdint>
#include <cmath>
#include <cstring>
namespace cg = cooperative_groups;

__device__ __forceinline__ int phase_tid(int wave_s) { int lane; asm volatile("v_mbcnt_lo_u32_b32 %0, -1, 0\n\tv_mbcnt_hi_u32_b32 %0, -1, %0" : "=v"(lane)); return wave_s * 64 + lane; }

namespace pg8 {
#define PG8_LAS __attribute__((address_space(3)))
typedef unsigned short bf16_t;
typedef short bf16x8 __attribute__((ext_vector_type(8)));
typedef float f32x4 __attribute__((ext_vector_type(4)));
typedef unsigned u32x4 __attribute__((ext_vector_type(4)));
constexpr int BM = 256, BK = 64, HALF = 128, HTB = HALF * BK * 2  , STAGE_BYTES = 8 * HTB, NXCD = 8, WGM = 8;

__host__ __device__ __forceinline__ int lds_byte(int r, int c) { const int st = (r >> 4) * 2 + (c >> 5), rr = r & 15, cc = c & 31, ob = rr * 64 + cc * 2; return st * 1024 + (ob ^ (((ob >> 9) & 1) << 5)); }
__host__ __device__ __forceinline__ void stage_rc(int b, int& R, int& C) { const int st = b / 1024, sb = b % 1024, swz = sb ^ (((sb >> 9) & 1) << 5); R = (st >> 1) * 16 + swz / 64; C = (st & 1) * 32 + (swz % 64) / 2; }
__host__ __device__ __forceinline__ int perm32(int rho) { const int n = rho >> 4, i = rho & 15; return 8 * (i >> 2) + 4 * n + (i & 3); }

struct Unit { int pm, pn; };
struct Gemm { const bf16_t* A; const bf16_t* Bt; int M, N, K, lda, ldb, kmid; };

struct StaticOrder {
    int nM, nN, nwg, G, c;
    __host__ __device__ void init(int M, int N, int G_, int c_) { nM = M / BM; nN = N / BM; nwg = nM * nN; G = G_; c = c_; }
    __host__ __device__ bool next(int i, Unit& u) const {
        const long L = (long)i * G + c; if (L >= nwg) return false;
        int wgid = (int)L; { const int q = nwg / NXCD, r = nwg % NXCD, xcd = wgid % NXCD, off = wgid / NXCD; wgid = (xcd < r ? xcd * (q + 1) : r * (q + 1) + (xcd - r) * q) + off; }
        const int nig = WGM * nN, gid = wgid / nig, fm = gid * WGM, gsz = (nM - fm) < WGM ? (nM - fm) : WGM;
        u.pm = fm + ((wgid % nig) % gsz); u.pn = (wgid % nig) / gsz; return true;
    }
    __device__ __forceinline__ void a_ready(const Unit&) const {}
    __device__ __forceinline__ void done(const Unit&) const {}
};


template <class Epi, class Sched, bool ALIGN_EPI = false, bool SP2 = false>
__device__ __forceinline__ void gemm_phase(PG8_LAS unsigned char* lds, const Gemm g, const Sched& S, const Epi& E, const int wave_s) {
    int tid_ = phase_tid(wave_s);
    const int tid = tid_, wid = __builtin_amdgcn_readfirstlane(tid >> 6), lane = tid & 63, wr = wid >> 2, wc = wid & 3, fr = lane & 15, fq = lane >> 4;
    const int K = g.K, nt = K / BK;
    unsigned voffA[2], voffB[2];
#pragma unroll
    for (int i = 0; i < 2; ++i) { int R, C; stage_rc(tid * 16 + i * 8192, R, C); const int Rb = Epi::PERM ? ((R & ~31) + perm32(R & 31)) : R;
        voffA[i] = (unsigned)(R * g.lda + C) * 2u; voffB[i] = (unsigned)(Rb * g.ldb + C) * 2u; }
    const size_t kstep = (size_t)(BK * 2);
    const size_t hstepA = (size_t)HALF * g.lda * 2, hstepB = (size_t)HALF * g.ldb * 2;
    const size_t tstepA = 2 * hstepA, tstepB = 2 * hstepB;
    const unsigned ldsw = (unsigned)wid * 1024u;
    const int aoff = lds_byte(wr * 64 + fr, fq * 8), boff = lds_byte(wc * 32 + fr, fq * 8);
#define PG8_SA(b, h) (((b) * 2 + (h)) * HTB)
#define PG8_SB(b, h) ((4 + (b) * 2 + (h)) * HTB)
#define PG8_STAGE(bufoff, gbase, voff) do { _Pragma("unroll") for (int _i = 0; _i < 2; ++_i) \
        __builtin_amdgcn_global_load_lds((const unsigned*)((const char*)(gbase) + (voff)[_i]), (PG8_LAS unsigned*)(lds + (bufoff) + ldsw + _i * 8192), 16, 0, 0); } while (0)
#define PG8_LDA(dst, b, h) do { _Pragma("unroll") for (int m = 0; m < 4; ++m) _Pragma("unroll") for (int k = 0; k < 2; ++k) dst[m][k] = *(const PG8_LAS bf16x8*)(lds + PG8_SA(b, h) + aoff + m * 2048 + k * 1024); } while (0)
#define PG8_LDB(dst, b, h) do { _Pragma("unroll") for (int n = 0; n < 2; ++n) _Pragma("unroll") for (int k = 0; k < 2; ++k) dst[n][k] = *(const PG8_LAS bf16x8*)(lds + PG8_SB(b, h) + boff + n * 2048 + k * 1024); } while (0)
#define PG8_MMA(ai, bj, At, Bt) do { __builtin_amdgcn_s_setprio(1); _Pragma("unroll") for (int m = 0; m < 4; ++m) _Pragma("unroll") for (int n = 0; n < 2; ++n) _Pragma("unroll") for (int k = 0; k < 2; ++k) \
        acc[ai][bj][m][n] = __builtin_amdgcn_mfma_f32_16x16x32_bf16(Bt[n][k], At[m][k], acc[ai][bj][m][n], 0, 0, 0); __builtin_amdgcn_s_setprio(0); } while (0)
#define PG8_WAIT_V(n) asm volatile("s_waitcnt vmcnt(" #n ")" ::: "memory")
#define PG8_WAIT_L(n) asm volatile("s_waitcnt lgkmcnt(" #n ")" ::: "memory")
#define PG8_BAR __builtin_amdgcn_s_barrier()
#define PG8_SCHED __builtin_amdgcn_sched_barrier(0)
    Unit cur, nxt; int ui = 0;
    if (!S.next(0, cur)) return;
    f32x4 acc[2][2][4][2];
#pragma unroll
    for (int a = 0; a < 2; ++a)
#pragma unroll
        for (int b = 0; b < 2; ++b)
#pragma unroll
            for (int m = 0; m < 4; ++m)
#pragma unroll
                for (int n = 0; n < 2; ++n) acc[a][b][m][n] = (f32x4){0.f, 0.f, 0.f, 0.f};
    bf16x8 At[4][2], B0[2][2], B1[2][2];
    const char* cA = (const char*)g.A + (size_t)cur.pm * tstepA; const char* cB = (const char*)g.Bt + (size_t)cur.pn * tstepB;
    S.a_ready(cur);
    if constexpr (SP2) {
        PG8_STAGE(PG8_SB(0, 0), cB, voffB); PG8_STAGE(PG8_SB(0, 1), cB + hstepB, voffB); PG8_STAGE(PG8_SA(0, 0), cA, voffA); PG8_STAGE(PG8_SA(0, 1), cA + hstepA, voffA);
        if (wr == 1) PG8_BAR;
        PG8_WAIT_V(2); PG8_BAR;
        PG8_STAGE(PG8_SB(1, 0), cB + kstep, voffB); PG8_STAGE(PG8_SA(1, 0), cA + kstep, voffA); PG8_STAGE(PG8_SB(1, 1), cB + hstepB + kstep, voffB);
        PG8_WAIT_V(6); PG8_BAR;
    } else {
        PG8_STAGE(PG8_SB(0, 0), cB, voffB); PG8_STAGE(PG8_SA(0, 0), cA, voffA); PG8_STAGE(PG8_SB(0, 1), cB + hstepB, voffB); PG8_STAGE(PG8_SA(0, 1), cA + hstepA, voffA);
        if (wr == 1) PG8_BAR;
        PG8_WAIT_V(4); PG8_BAR;
        PG8_STAGE(PG8_SB(1, 0), cB + kstep, voffB); PG8_STAGE(PG8_SA(1, 0), cA + kstep, voffA); PG8_STAGE(PG8_SB(1, 1), cB + hstepB + kstep, voffB);
        PG8_WAIT_V(6); PG8_BAR;
    }
    for (;;) {
        const bool has_next = S.next(ui + 1, nxt);
        const char* nA = has_next ? (const char*)g.A + (size_t)nxt.pm * tstepA : cA; const char* nB = has_next ? (const char*)g.Bt + (size_t)nxt.pn * tstepB : cB;
        for (int t = 0; t < nt; t += 2) {
            const bool last = (t == nt - 2);
            if constexpr (Epi::HAS_MID) { if (t == g.kmid) { const int lane_e = phase_tid(0), fr_e = lane_e & 15, fq_e = lane_e >> 4; E.mid(acc, cur, wr, wc, fr_e, fq_e); } }
            const char* a1 = cA + (size_t)(t + 1) * kstep;
            const char* a2 = last ? nA : cA + (size_t)(t + 2) * kstep; const char* b2 = last ? nB : cB + (size_t)(t + 2) * kstep;
            const char* a3 = a2 + kstep; const char* b3 = b2 + kstep;
            if (last && has_next) S.a_ready(nxt);
            if constexpr (SP2) {
            PG8_LDB(B0, 0, 0); PG8_LDB(B1, 0, 1); PG8_SCHED; PG8_LDA(At, 0, 0); PG8_STAGE(PG8_SA(1, 1), a1 + hstepA, voffA);
            PG8_WAIT_V(8); PG8_WAIT_L(0); PG8_BAR; PG8_MMA(0, 0, At, B0); PG8_MMA(0, 1, At, B1); PG8_BAR; PG8_SCHED;
            PG8_LDA(At, 0, 1); PG8_STAGE(PG8_SB(0, 0), b2, voffB); PG8_STAGE(PG8_SB(0, 1), b2 + hstepB, voffB); PG8_STAGE(PG8_SA(0, 0), a2, voffA);
            PG8_WAIT_V(8); PG8_WAIT_L(0); PG8_BAR; PG8_MMA(1, 0, At, B0); PG8_MMA(1, 1, At, B1); PG8_BAR; PG8_SCHED;
            PG8_LDB(B0, 1, 0); PG8_LDB(B1, 1, 1); PG8_SCHED; PG8_LDA(At, 1, 0); PG8_STAGE(PG8_SA(0, 1), a2 + hstepA, voffA);
            PG8_WAIT_V(8); PG8_WAIT_L(0); PG8_BAR; PG8_MMA(0, 0, At, B0); PG8_MMA(0, 1, At, B1); PG8_BAR; PG8_SCHED;
            PG8_LDA(At, 1, 1); PG8_STAGE(PG8_SB(1, 0), b3, voffB); PG8_STAGE(PG8_SB(1, 1), b3 + hstepB, voffB); PG8_STAGE(PG8_SA(1, 0), a3, voffA);
            PG8_WAIT_V(8); PG8_WAIT_L(0); PG8_BAR; PG8_MMA(1, 0, At, B0); PG8_MMA(1, 1, At, B1); PG8_BAR; PG8_SCHED;
            } else {
            PG8_LDB(B0, 0, 0); PG8_SCHED; PG8_LDA(At, 0, 0); PG8_STAGE(PG8_SA(1, 1), a1 + hstepA, voffA);
            PG8_WAIT_L(8); PG8_BAR; PG8_WAIT_L(0); PG8_MMA(0, 0, At, B0); PG8_BAR; PG8_SCHED;
            PG8_LDB(B1, 0, 1); PG8_STAGE(PG8_SB(0, 0), b2, voffB);
            PG8_BAR; PG8_WAIT_L(0); PG8_MMA(0, 1, At, B1); PG8_BAR;
            PG8_LDA(At, 0, 1); PG8_STAGE(PG8_SA(0, 0), a2, voffA);
            PG8_BAR; PG8_WAIT_L(0); PG8_MMA(1, 0, At, B0); PG8_BAR; PG8_SCHED;
            PG8_STAGE(PG8_SB(0, 1), b2 + hstepB, voffB);
            PG8_WAIT_V(6); PG8_BAR; PG8_MMA(1, 1, At, B1); PG8_BAR;
            PG8_LDB(B0, 1, 0); PG8_SCHED; PG8_LDA(At, 1, 0); PG8_STAGE(PG8_SA(0, 1), a2 + hstepA, voffA);
            PG8_WAIT_L(8); PG8_BAR; PG8_WAIT_L(0); PG8_MMA(0, 0, At, B0); PG8_BAR; PG8_SCHED;
            PG8_LDB(B1, 1, 1); PG8_STAGE(PG8_SB(1, 0), b3, voffB);
            PG8_BAR; PG8_WAIT_L(0); PG8_MMA(0, 1, At, B1); PG8_BAR;
            PG8_LDA(At, 1, 1); PG8_STAGE(PG8_SA(1, 0), a3, voffA);
            PG8_BAR; PG8_WAIT_L(0); PG8_MMA(1, 0, At, B0); PG8_BAR; PG8_SCHED;
            PG8_STAGE(PG8_SB(1, 1), b3 + hstepB, voffB);
            PG8_WAIT_V(6); PG8_BAR; PG8_MMA(1, 1, At, B1); PG8_BAR;
            }
        }
        if constexpr (ALIGN_EPI) { if (wr == 0) PG8_BAR; }
        if constexpr (!Epi::AFTER_DRAIN) { const int lane_e = phase_tid(0), fr_e = lane_e & 15, fq_e = lane_e >> 4;
            E(acc, cur, wr, wc, fr_e, fq_e); S.done(cur); }
        if (!has_next) break;
#pragma unroll
        for (int a = 0; a < 2; ++a)
#pragma unroll
            for (int b = 0; b < 2; ++b)
#pragma unroll
                for (int m = 0; m < 4; ++m)
#pragma unroll
                    for (int n = 0; n < 2; ++n) acc[a][b][m][n] = (f32x4){0.f, 0.f, 0.f, 0.f};
        cur = nxt; cA = nA; cB = nB; ++ui;
        if constexpr (ALIGN_EPI) { if (wr == 1) PG8_BAR; }
    }
    PG8_WAIT_V(0);
    if constexpr (!ALIGN_EPI) { if (wr == 0) PG8_BAR; }
    PG8_BAR;
    if constexpr (Epi::AFTER_DRAIN) { E.fused(acc, cur, wr, wc, fr, fq, lds, wid, lane); S.done(cur); }
#undef PG8_SA
#undef PG8_SB
#undef PG8_STAGE
#undef PG8_LDA
#undef PG8_LDB
#undef PG8_MMA
#undef PG8_WAIT_V
#undef PG8_WAIT_L
#undef PG8_BAR
#undef PG8_SCHED
}
}


#define LAS __attribute__((address_space(3)))
typedef unsigned short bf16_t;
typedef short bf16x8 __attribute__((ext_vector_type(8)));
typedef float f32x4 __attribute__((ext_vector_type(4)));
typedef float f32x16 __attribute__((ext_vector_type(16)));
typedef unsigned u32x4 __attribute__((ext_vector_type(4)));
typedef unsigned u32x2 __attribute__((ext_vector_type(2)));

constexpr int NB = 8, SEQ = 4096, NMETA = 16, DM = 1024, TREAL = NB * SEQ, TTOT = TREAL + NB * NMETA, MP = 33024, LPOS = SEQ + NMETA;
constexpr int NMAIN = 1792, DFF = 2816, NGU = 2 * DFF, QLORA = 384, KVLORA = 256;
constexpr float EPS = 1e-6f;
constexpr int NTHR = 512, NWAVE = 8;
constexpr int LDS_BYTES = 131072;

constexpr size_t al256(size_t x) { return (x + 255) & ~(size_t)255; }
constexpr size_t WS_ROPE = 0;
constexpr size_t ROPE_BYTES = al256(2ull * LPOS * 16 * 4);
constexpr size_t WS_SS = WS_ROPE + ROPE_BYTES;
constexpr size_t SS_FLOATS = 2ull * 48 * MP;
constexpr size_t WS_HMETA = WS_SS + al256(SS_FLOATS * 4);
constexpr size_t WS_W = WS_HMETA + 256ull * 1024 * 4;
constexpr size_t W_MAIN = 0, W_V = W_MAIN + 1792ull * 1024 * 2, W_UQ = W_V + 512ull * 1024 * 2, W_UK = W_UQ + 768ull * 384 * 2, W_UV = W_UK + 512ull * 256 * 2,
                 W_O = W_UV + 512ull * 256 * 2, W_GU = W_O + 1024ull * 1024 * 2, W_D = W_GU + 5632ull * 1024 * 2, W_LAYER = W_D + 1024ull * 2816 * 2;
constexpr size_t WS_XN = WS_W + 2 * W_LAYER;
constexpr size_t WS_G = WS_XN + (size_t)MP * 1024 * 2;
constexpr size_t G_QK = 0, G_CQ = G_QK + (size_t)MP * 1024 * 2, G_CKV = G_CQ + (size_t)MP * 384 * 2, G_KR = G_CKV + (size_t)MP * 256 * 2, G_VTS = G_KR + (size_t)MP * 32 * 2,
                 G_QM = G_VTS + 512ull * MP * 2, G_KN = G_QM + (size_t)MP * 768 * 2, G_VTM = G_KN + (size_t)MP * 512 * 2, G_O = G_VTM + 512ull * MP * 2, G_END = G_O + (size_t)MP * 1024 * 2;
constexpr size_t G_MIX = 0, G_ACT = 0, G_FFN = G_ACT + (size_t)MP * DFF * 2;
static_assert(G_MIX + (size_t)MP * 1024 * 4 <= G_QM, "mix overlays only dead buffers");
static_assert(G_FFN + (size_t)MP * 1024 * 4 <= G_END, "ffn inside group");
constexpr size_t WS_END = WS_G + G_END;

struct Params {
    const float* in[17];
    float* out; unsigned char* ws;
    float inv_freq[16];
    int ph_lo, ph_hi;
};

typedef __bf16 bf16x2_t __attribute__((ext_vector_type(2)));
typedef float f32x2_t __attribute__((ext_vector_type(2)));
__device__ __forceinline__ unsigned pk_bf16(float lo, float hi) { const f32x2_t v = {lo, hi}; const bf16x2_t b = __builtin_convertvector(v, bf16x2_t); return __builtin_bit_cast(unsigned, b); }
__device__ __forceinline__ float wave_sum(float v) {
#pragma unroll
    for (int o = 1; o < 64; o <<= 1) v += __shfl_xor(v, o);
    return v;
}
__device__ __forceinline__ int row_pos(int row) { return row < TREAL ? NMETA + (row & (SEQ - 1)) : ((row - TREAL) & (NMETA - 1)); }

namespace epi {
using pg8::Unit;
typedef const f32x4 (&AccC)[2][2][4][2];
typedef f32x4 (&AccM)[2][2][4][2];
__device__ __forceinline__ float sum4(const f32x4 a) { return (a[0] + a[1]) + (a[2] + a[3]); }
__device__ __forceinline__ float ss_sum8(const float* p) { return sum4(*(const f32x4*)p) + sum4(*(const f32x4*)(p + 4)); }
__device__ __forceinline__ float ss_sum12(const float* p) { return (sum4(*(const f32x4*)p) + sum4(*(const f32x4*)(p + 4))) + sum4(*(const f32x4*)(p + 8)); }

struct Main {
    static constexpr bool PERM = false, AFTER_DRAIN = false, HAS_MID = false;
    bf16_t *qk, *cq, *ckv, *kr; float* ss_c; const float *cosT, *sinT;
    template <int BJ, int MODE, bool SS>
    __device__ __forceinline__ void half(AccC acc, bf16_t* dst, int ldc, int c0, float* ss, int slot, int rbase, int fq) const {
#pragma unroll
        for (int ai = 0; ai < 2; ++ai)
#pragma unroll
            for (int m = 0; m < 4; ++m) {
                const int row = rbase + ai * 128 + m * 16;
                f32x4 v0 = acc[ai][BJ][m][0], v1 = acc[ai][BJ][m][1];
                if (MODE == 1) {
                    const int pos = row_pos(row);
                    const f32x4 c = *(const f32x4*)(cosT + pos * 16 + 4 * fq), s = *(const f32x4*)(sinT + pos * 16 + 4 * fq);
                    const f32x4 a = v0 * c - v1 * s, b = v1 * c + v0 * s; v0 = a; v1 = b;
                }
                bf16_t* p = dst + (size_t)row * ldc + c0;
                *(u32x2*)p = (u32x2){pk_bf16(v0[0], v0[1]), pk_bf16(v0[2], v0[3])};
                *(u32x2*)(p + 16) = (u32x2){pk_bf16(v1[0], v1[1]), pk_bf16(v1[2], v1[3])};
                if (SS) {
                    float s = (v0[0] * v0[0] + v0[1] * v0[1]) + (v0[2] * v0[2] + v0[3] * v0[3]) + (v1[0] * v1[0] + v1[1] * v1[1]) + (v1[2] * v1[2] + v1[3] * v1[3]);
                    s += __shfl_xor(s, 16); s += __shfl_xor(s, 32);
                    if (fq == 0) ss[(size_t)row * 32 + slot] = s;
                }
            }
    }
    __device__ __forceinline__ void operator()(AccC acc, const Unit& u, int wr, int wc, int fr, int fq) const {
        const int pn = u.pn, rbase = u.pm * 256 + wr * 64 + fr, cb = 32 * wc + 4 * fq;
        if (pn < 4) { half<0, 0, false>(acc, qk, 1024, pn * 256 + cb, nullptr, 0, rbase, fq); half<1, 0, false>(acc, qk, 1024, pn * 256 + 128 + cb, nullptr, 0, rbase, fq); }
        else if (pn == 4) { half<0, 0, true>(acc, cq, 384, cb, ss_c, wc, rbase, fq); half<1, 0, true>(acc, cq, 384, 128 + cb, ss_c, 4 + wc, rbase, fq); }
        else if (pn == 5) { half<0, 0, true>(acc, cq, 384, 256 + cb, ss_c, 8 + wc, rbase, fq); half<1, 0, true>(acc, ckv, 256, cb, ss_c, 16 + wc, rbase, fq); }
        else { half<0, 0, true>(acc, ckv, 256, 128 + cb, ss_c, 20 + wc, rbase, fq); if (wc == 0) half<1, 1, false>(acc, kr, 32, 4 * fq, nullptr, 0, rbase, fq); }
    }
};
struct Bf16R {
    static constexpr bool PERM = false, AFTER_DRAIN = false, HAS_MID = false;
    bf16_t* O; int ldc; const float* ss_row; float invn_row;
    __device__ __forceinline__ void operator()(AccC acc, const Unit& u, int wr, int wc, int fr, int fq) const {
        const int rbase = u.pm * 256 + wr * 64 + fr, cbase = u.pn * 256 + 32 * wc + 4 * fq;
#pragma unroll
        for (int ai = 0; ai < 2; ++ai)
#pragma unroll
            for (int m = 0; m < 4; ++m) {
                const int row = rbase + ai * 128 + m * 16;
                const float rs = ss_row ? __builtin_amdgcn_rsqf(ss_sum8(ss_row + (size_t)row * 32) * invn_row + EPS) : 1.f;
#pragma unroll
                for (int bj = 0; bj < 2; ++bj)
#pragma unroll
                    for (int n = 0; n < 2; ++n) {
                        const f32x4 v = acc[ai][bj][m][n] * rs;
                        *(u32x2*)(O + (size_t)row * ldc + cbase + bj * 128 + n * 16) = (u32x2){pk_bf16(v[0], v[1]), pk_bf16(v[2], v[3])};
                    }
                asm volatile("" ::: "memory");
            }
    }
};
struct Bf16C {
    static constexpr bool PERM = false, AFTER_DRAIN = false, HAS_MID = false;
    bf16_t* O; int ldc; const float* ss_col; float invn_col;
    __device__ __forceinline__ void operator()(AccC acc, const Unit& u, int wr, int wc, int fr, int fq) const {
        const int rbase = u.pm * 256 + wr * 64 + fr, cbase = u.pn * 256 + 32 * wc + 4 * fq;
#pragma unroll
        for (int bj = 0; bj < 2; ++bj)
#pragma unroll
            for (int n = 0; n < 2; ++n) {
                f32x4 cs;
#pragma unroll
                for (int i = 0; i < 4; ++i) cs[i] = __builtin_amdgcn_rsqf(ss_sum8(ss_col + (size_t)(cbase + bj * 128 + n * 16 + i) * 32) * invn_col + EPS);
#pragma unroll
                for (int ai = 0; ai < 2; ++ai)
#pragma unroll
                    for (int m = 0; m < 4; ++m) {
                        const int row = rbase + ai * 128 + m * 16;
                        const f32x4 v = acc[ai][bj][m][n] * cs;
                        *(u32x2*)(O + (size_t)row * ldc + cbase + bj * 128 + n * 16) = (u32x2){pk_bf16(v[0], v[1]), pk_bf16(v[2], v[3])};
                    }
                asm volatile("" ::: "memory");
            }
    }
};
struct QMla {
    static constexpr bool PERM = false, AFTER_DRAIN = false, HAS_MID = false;
    bf16_t* O; const float* ss; const float *cosT, *sinT;
    __device__ __forceinline__ void operator()(AccC acc, const Unit& u, int wr, int wc, int fr, int fq) const {
        const int rbase = u.pm * 256 + wr * 64 + fr;
#pragma unroll
        for (int ai = 0; ai < 2; ++ai)
#pragma unroll
            for (int m = 0; m < 4; ++m) {
                const int row = rbase + ai * 128 + m * 16;
                const float rs = __builtin_amdgcn_rsqf(ss_sum12(ss + (size_t)row * 32) * (1.f / QLORA) + EPS);
                const int pos = row_pos(row);
#pragma unroll
                for (int bj = 0; bj < 2; ++bj) {
                    const int colg = u.pn * 256 + bj * 128 + 32 * wc;
                    f32x4 v0 = acc[ai][bj][m][0] * rs, v1 = acc[ai][bj][m][1] * rs;
                    if (((colg >> 5) % 3) == 2) {
                        const f32x4 c = *(const f32x4*)(cosT + pos * 16 + 4 * fq), s = *(const f32x4*)(sinT + pos * 16 + 4 * fq);
                        const f32x4 a = v0 * c - v1 * s, b = v1 * c + v0 * s; v0 = a; v1 = b;
                    }
                    bf16_t* p = O + (size_t)row * 768 + colg + 4 * fq;
                    *(u32x2*)p = (u32x2){pk_bf16(v0[0], v0[1]), pk_bf16(v0[2], v0[3])};
                    *(u32x2*)(p + 16) = (u32x2){pk_bf16(v1[0], v1[1]), pk_bf16(v1[2], v1[3])};
                }
                asm volatile("" ::: "memory");
            }
    }
};
struct Wo {
    static constexpr bool PERM = false, AFTER_DRAIN = false, HAS_MID = true;
    bf16_t* O; const float* ss_o;
    __device__ __forceinline__ void mid(AccM acc, const Unit& u, int wr, int wc, int fr, int fq) const {
        int rbase = u.pm * 256 + wr * 64 + fr; asm volatile("" : "+v"(rbase) :: "memory");
#pragma unroll
        for (int ai = 0; ai < 2; ++ai)
#pragma unroll
            for (int m = 0; m < 4; ++m) {
                const int row = rbase + ai * 128 + m * 16;
                const float r = __builtin_amdgcn_rsqf(ss_sum8(ss_o + (size_t)row * 16) * (1.f / 512) + EPS) * __builtin_amdgcn_sqrtf(ss_sum8(ss_o + (size_t)row * 16 + 8) * (1.f / 512) + EPS);
#pragma unroll
                for (int bj = 0; bj < 2; ++bj)
#pragma unroll
                    for (int n = 0; n < 2; ++n) acc[ai][bj][m][n] *= r;
            }
    }
    __device__ __forceinline__ void operator()(AccC acc, const Unit& u, int wr, int wc, int fr, int fq) const {
        const int rbase = u.pm * 256 + wr * 64 + fr, cbase = u.pn * 256 + 32 * wc + 4 * fq;
#pragma unroll
        for (int ai = 0; ai < 2; ++ai)
#pragma unroll
            for (int m = 0; m < 4; ++m) {
                const int row = rbase + ai * 128 + m * 16;
                const float r = __builtin_amdgcn_rsqf(ss_sum8(ss_o + (size_t)row * 16 + 8) * (1.f / 512) + EPS);
#pragma unroll
                for (int bj = 0; bj < 2; ++bj)
#pragma unroll
                    for (int n = 0; n < 2; ++n) { const f32x4 v = acc[ai][bj][m][n] * r; *(u32x2*)(O + (size_t)row * 1024 + cbase + bj * 128 + n * 16) = (u32x2){pk_bf16(v[0], v[1]), pk_bf16(v[2], v[3])}; }
            }
    }
};
struct GateUp {
    static constexpr bool PERM = false, AFTER_DRAIN = false, HAS_MID = false;
    bf16_t* O;
    __device__ __forceinline__ void operator()(AccC acc, const Unit& u, int wr, int wc, int fr, int fq) const {
        const int rbase = u.pm * 256 + wr * 64 + fr, cbase = u.pn * 128 + 16 * wc + 4 * fq;
#pragma unroll
        for (int ai = 0; ai < 2; ++ai)
#pragma unroll
            for (int m = 0; m < 4; ++m) {
                const int row = rbase + ai * 128 + m * 16;
#pragma unroll
                for (int bj = 0; bj < 2; ++bj) {
                    const f32x4 g = acc[ai][bj][m][0], up = acc[ai][bj][m][1]; f32x4 a;
#pragma unroll
                    for (int i = 0; i < 4; ++i) a[i] = g[i] * __builtin_amdgcn_rcpf(1.f + __builtin_amdgcn_exp2f(-1.44269504089f * g[i])) * up[i];
                    *(u32x2*)(O + (size_t)row * DFF + cbase + bj * 64) = (u32x2){pk_bf16(a[0], a[1]), pk_bf16(a[2], a[3])};
                }
            }
    }
};
struct F32Out {
    static constexpr bool PERM = false, AFTER_DRAIN = false, HAS_MID = false;
    bf16_t* O;
    __device__ __forceinline__ void operator()(AccC acc, const Unit& u, int wr, int wc, int fr, int fq) const {
        const int rbase = u.pm * 256 + wr * 64 + fr, cbase = u.pn * 256 + 32 * wc + 4 * fq;
#pragma unroll
        for (int ai = 0; ai < 2; ++ai)
#pragma unroll
            for (int m = 0; m < 4; ++m) {
                const int row = rbase + ai * 128 + m * 16;
#pragma unroll
                for (int bj = 0; bj < 2; ++bj)
#pragma unroll
                    for (int n = 0; n < 2; ++n) { const f32x4 v = acc[ai][bj][m][n]; *(u32x2*)(O + (size_t)row * 1024 + cbase + bj * 128 + n * 16) = (u32x2){pk_bf16(v[0], v[1]), pk_bf16(v[2], v[3])}; }
            }
    }
};
}

template <class Epi>
__device__ __forceinline__ void run_gemm(LAS unsigned char* lds, const bf16_t* A, int lda, const bf16_t* Bt, int ldb, int M, int N, int K, int kmid, int rot, const Epi& E, int wave_s) {
    pg8::Gemm g{A, Bt, M, N, K, lda, ldb, kmid};
    int bx = (int)blockIdx.x, G = (int)gridDim.x; asm volatile("" : "+s"(bx), "+s"(G));
    pg8::StaticOrder S; S.init(M, N, G, (bx + G - (rot % G)) % G);
    pg8::gemm_phase<Epi, pg8::StaticOrder, true, true>(lds, g, S, E, wave_s);
}

__device__ __forceinline__ void tr_item(const float* W, int ldw, int scol0, int k0, const float* kg0, const float* kg1, float scale, bf16_t* WT, int K, int drow0, int mode, LAS float* scr, int lane) {
    f32x4 v[8];
#pragma unroll
    for (int i = 0; i < 8; ++i) v[i] = *(const f32x4*)(W + (size_t)(k0 + 8 * i + (lane >> 3)) * ldw + scol0 + 4 * (lane & 7));
#pragma unroll
    for (int i = 0; i < 8; ++i) {
        const int kk = 8 * i + (lane >> 3), k = k0 + kk; float g = scale;
        if (kg0) g *= (kg1 && k >= 512) ? kg1[k - 512] : kg0[k];
        LAS float* d = scr + kk * 33 + 4 * (lane & 7);
        d[0] = v[i][0] * g; d[1] = v[i][1] * g; d[2] = v[i][2] * g; d[3] = v[i][3] * g;
    }
    asm volatile("s_waitcnt lgkmcnt(0)" ::: "memory");
    const int c = lane & 7;
#pragma unroll
    for (int j = 0; j < 4; ++j) {
        const int n = (lane >> 3) + 8 * j; const LAS float* s = scr + (8 * c) * 33 + n;
        u32x4 o; o.x = pk_bf16(s[0 * 33], s[1 * 33]); o.y = pk_bf16(s[2 * 33], s[3 * 33]); o.z = pk_bf16(s[4 * 33], s[5 * 33]); o.w = pk_bf16(s[6 * 33], s[7 * 33]);
        const int drow = drow0 + (mode ? 32 * (n >> 4) + (n & 15) : n);
        *(u32x4*)(WT + (size_t)drow * K + k0 + 8 * c) = o;
    }
    asm volatile("s_waitcnt lgkmcnt(0)" ::: "memory");
}

constexpr float SCALE_QMLA = 0.10206207261596575f * 1.4426950408889634f;
constexpr int ITEMS_PER_LAYER = 6112;

__device__ __forceinline__ void convert_item(const Params& p, int layer, int it, LAS float* scr, int lane) {
    unsigned char* wl = p.ws + WS_W + (size_t)layer * W_LAYER;
    const float* w_in = p.in[2] + (size_t)layer * 1024 * 2208;
    constexpr int IT_SEG[12] = {0, 256, 512, 768, 1104, 1248, 1312, 1376, 1888, 3296, 4704, 6112};
    int seg = 0;
#pragma unroll
    for (int s = 1; s < 11; ++s) if (it >= IT_SEG[s]) seg = s;
    const int r = it - IT_SEG[seg];
    switch (seg) {
    case 0: { const int nb = r % 16, kb = r / 16; tr_item(w_in, 2208, 32 * nb, 64 * kb, nullptr, nullptr, 0.125f, (bf16_t*)(wl + W_MAIN), 1024, 32 * nb, 0, scr, lane); break; }
    case 1: { const int nb = r % 16, kb = r / 16; tr_item(w_in, 2208, 512 + 32 * nb, 64 * kb, nullptr, nullptr, 1.f, (bf16_t*)(wl + W_MAIN), 1024, 512 + 32 * nb, 0, scr, lane); break; }
    case 2: { const int nb = r % 16, kb = r / 16; tr_item(w_in, 2208, 1024 + 32 * nb, 64 * kb, nullptr, nullptr, 1.f, (bf16_t*)(wl + W_V), 1024, 32 * nb, 0, scr, lane); break; }
    case 3: { const int nb = r % 21, kb = r / 21; tr_item(w_in, 2208, 1536 + 32 * nb, 64 * kb, nullptr, nullptr, 1.f, (bf16_t*)(wl + W_MAIN), 1024, 1024 + 32 * nb, 0, scr, lane); break; }
    case 4: { const int nb = r % 24, kb = r / 24; tr_item(p.in[5] + (size_t)layer * 384 * 768, 768, 32 * nb, 64 * kb, p.in[3] + layer * 384, nullptr, SCALE_QMLA, (bf16_t*)(wl + W_UQ), 384, 32 * nb, 0, scr, lane); break; }
    case 5: { const int nb = r % 16, kb = r / 16; const int n0 = 32 * nb; tr_item(p.in[6] + (size_t)layer * 256 * 1024, 1024, 128 * (n0 >> 6) + (n0 & 63), 64 * kb, p.in[4] + layer * 256, nullptr, 1.f, (bf16_t*)(wl + W_UK), 256, n0, 0, scr, lane); break; }
    case 6: { const int nb = r % 16, kb = r / 16; const int n0 = 32 * nb; tr_item(p.in[6] + (size_t)layer * 256 * 1024, 1024, 128 * (n0 >> 6) + 64 + (n0 & 63), 64 * kb, p.in[4] + layer * 256, nullptr, 1.f, (bf16_t*)(wl + W_UV), 256, n0, 0, scr, lane); break; }
    case 7: { const int nb = r % 32, kb = r / 32; tr_item(p.in[9] + (size_t)layer * 1024 * 1024, 1024, 32 * nb, 64 * kb, p.in[7] + layer * 512, p.in[8] + layer * 512, 1.f, (bf16_t*)(wl + W_O), 1024, 32 * nb, 0, scr, lane); break; }
    case 8: { const int nb = r % 88, kb = r / 88; tr_item(p.in[14] + (size_t)layer * 1024 * DFF, DFF, 32 * nb, 64 * kb, nullptr, nullptr, 1.f, (bf16_t*)(wl + W_GU), 1024, 64 * nb, 1, scr, lane); break; }
    case 9: { const int nb = r % 88, kb = r / 88; tr_item(p.in[15] + (size_t)layer * 1024 * DFF, DFF, 32 * nb, 64 * kb, nullptr, nullptr, 1.f, (bf16_t*)(wl + W_GU), 1024, 64 * nb + 16, 1, scr, lane); break; }
    default: { const int nb = r % 32, kb = r / 32; tr_item(p.in[16] + (size_t)layer * DFF * 1024, 1024, 32 * nb, 64 * kb, nullptr, nullptr, 1.f, (bf16_t*)(wl + W_D), DFF, 32 * nb, 0, scr, lane); break; }
    }
}

__device__ __forceinline__ void sincos_f64(double a, double& s, double& c) {
    const double k = rint(a * 0.63661977236758134308);
    double r = fma(-k, 1.57079632679489655800e+00, a); r = fma(-k, 6.12323399573676603587e-17, r);
    const double r2 = r * r;
    double sp = -1.0 / 1307674368000.0; sp = fma(sp, r2, 1.0 / 6227020800.0); sp = fma(sp, r2, -1.0 / 39916800.0); sp = fma(sp, r2, 1.0 / 362880.0); sp = fma(sp, r2, -1.0 / 5040.0); sp = fma(sp, r2, 1.0 / 120.0); sp = fma(sp, r2, -1.0 / 6.0);
    const double sr = fma(sp * r2, r, r);
    double cp = 1.0 / 20922789888000.0; cp = fma(cp, r2, -1.0 / 87178291200.0); cp = fma(cp, r2, 1.0 / 479001600.0); cp = fma(cp, r2, -1.0 / 3628800.0); cp = fma(cp, r2, 1.0 / 40320.0); cp = fma(cp, r2, -1.0 / 720.0); cp = fma(cp, r2, 1.0 / 24.0); cp = fma(cp, r2, -0.5);
    const double cr = fma(cp, r2, 1.0);
    const int q = ((int)k) & 3;
    s = (q == 0) ? sr : (q == 1) ? cr : (q == 2) ? -sr : -cr;
    c = (q == 0) ? cr : (q == 1) ? -sr : (q == 2) ? -cr : sr;
}

template <int R>
__device__ __forceinline__ void row_step(const bf16_t* const (&y)[R], const float* gy, float* const (&hrow)[R], const float* const (&hsrc)[R], const float* gx, bf16_t* const (&xn)[R], bool has_y, bool has_xn, int lane) {
    f32x4 v[R][4], t[R][4];
#pragma unroll
    for (int r = 0; r < R; ++r)
#pragma unroll
        for (int j = 0; j < 4; ++j) { v[r][j] = *((const f32x4*)hsrc[r] + lane + 64 * j); if (has_y) { const u32x2 w = *((const u32x2*)y[r] + lane + 64 * j); t[r][j] = (f32x4){__uint_as_float(w.x << 16), __uint_as_float(w.x & 0xffff0000u), __uint_as_float(w.y << 16), __uint_as_float(w.y & 0xffff0000u)}; } }
    if (has_y) {
        f32x4 g[4];
#pragma unroll
        for (int j = 0; j < 4; ++j) g[j] = *((const f32x4*)gy + lane + 64 * j);
        float s[R];
#pragma unroll
        for (int r = 0; r < R; ++r) { s[r] = 0.f;
#pragma unroll
            for (int j = 0; j < 4; ++j) s[r] += (t[r][j][0] * t[r][j][0] + t[r][j][1] * t[r][j][1]) + (t[r][j][2] * t[r][j][2] + t[r][j][3] * t[r][j][3]); }
#pragma unroll
        for (int o = 1; o < 64; o <<= 1)
#pragma unroll
            for (int r = 0; r < R; ++r) s[r] += __shfl_xor(s[r], o);
#pragma unroll
        for (int r = 0; r < R; ++r) { const float rs = 1.0f / sqrtf(s[r] * (1.f / DM) + EPS);
#pragma unroll
            for (int j = 0; j < 4; ++j) v[r][j] += t[r][j] * rs * g[j]; }
    }
#pragma unroll
    for (int r = 0; r < R; ++r)
#pragma unroll
        for (int j = 0; j < 4; ++j) *((f32x4*)hrow[r] + lane + 64 * j) = v[r][j];
    if (has_xn) {
        f32x4 g[4];
#pragma unroll
        for (int j = 0; j < 4; ++j) g[j] = *((const f32x4*)gx + lane + 64 * j);
        float s[R];
#pragma unroll
        for (int r = 0; r < R; ++r) { s[r] = 0.f;
#pragma unroll
            for (int j = 0; j < 4; ++j) s[r] += (v[r][j][0] * v[r][j][0] + v[r][j][1] * v[r][j][1]) + (v[r][j][2] * v[r][j][2] + v[r][j][3] * v[r][j][3]); }
#pragma unroll
        for (int o = 1; o < 64; o <<= 1)
#pragma unroll
            for (int r = 0; r < R; ++r) s[r] += __shfl_xor(s[r], o);
#pragma unroll
        for (int r = 0; r < R; ++r) { const float rs = 1.0f / sqrtf(s[r] * (1.f / DM) + EPS);
#pragma unroll
            for (int j = 0; j < 4; ++j) { const f32x4 o = v[r][j] * rs * g[j]; *((u32x2*)xn[r] + lane + 64 * j) = (u32x2){pk_bf16(o[0], o[1]), pk_bf16(o[2], o[3])}; } }
    }
}
__device__ __forceinline__ float* h_row(const Params& p, int row) { return row < TREAL ? p.out + (size_t)row * DM : (float*)(p.ws + WS_HMETA) + (size_t)(row - TREAL) * DM; }

__device__ __forceinline__ void phase_prologue(const Params& p, LAS unsigned char* lds, int wave_s) {
    int tid_ = phase_tid(wave_s);
    const int tid = tid_, lane = tid & 63, wave = tid >> 6, G = gridDim.x;
    const int gt = blockIdx.x * NTHR + tid, NGT = G * NTHR, gw = blockIdx.x * NWAVE + wave, NGW = G * NWAVE;
    float* cosT = (float*)(p.ws + WS_ROPE); float* sinT = cosT + LPOS * 16;
    for (int i = gt; i < LPOS * 16; i += NGT) { const int pos = i >> 4, j = i & 15; const float ang = (float)pos * p.inv_freq[j]; double s, c; sincos_f64((double)ang, s, c); cosT[i] = (float)c; sinT[i] = (float)s; }
    for (int l = 0; l < 2; ++l) {
        u32x4* z = (u32x4*)(p.ws + WS_W + (size_t)l * W_LAYER + W_MAIN + 1696ull * 1024 * 2);
        for (int i = gt; i < 96 * 1024 * 2 / 16; i += NGT) z[i] = (u32x4){0u, 0u, 0u, 0u};
    }
    LAS float* scr = (LAS float*)(lds + wave * 16384);
    for (int it = gw; it < 2 * ITEMS_PER_LAYER; it += NGW) { const int layer = it >= ITEMS_PER_LAYER ? 1 : 0; convert_item(p, layer, it - layer * ITEMS_PER_LAYER, scr, lane); }
    bf16_t* xn = (bf16_t*)(p.ws + WS_XN);
    constexpr int RR = 4;
    for (int row0 = gw * RR; row0 < TTOT; row0 += NGW * RR) {
        const float* src[RR]; float* hr[RR]; bf16_t* xr[RR]; const bf16_t* yy[RR];
#pragma unroll
        for (int r = 0; r < RR; ++r) { const int row = row0 + r; src[r] = row < TREAL ? p.in[0] + (size_t)row * DM : p.in[1] + (size_t)((row - TREAL) & 15) * DM; hr[r] = h_row(p, row); xr[r] = xn + (size_t)row * DM; yy[r] = nullptr; }
        row_step<RR>(yy, nullptr, hr, src, p.in[10], xr, false, true, lane);
    }
}
__device__ __forceinline__ void phase_rows(const Params& p, const bf16_t* y, const float* gy, const float* gx, bool make_xn, int nrows, int wave_s) {
    int tid_ = phase_tid(wave_s);
    const int tid = tid_, lane = tid & 63, wave = tid >> 6, gw = blockIdx.x * NWAVE + wave, NGW = gridDim.x * NWAVE;
    bf16_t* xn = (bf16_t*)(p.ws + WS_XN);
    constexpr int RR = 4;
    for (int row0 = gw * RR; row0 < nrows; row0 += NGW * RR) {
        const float* src[RR]; float* hr[RR]; bf16_t* xr[RR]; const bf16_t* yy[RR];
#pragma unroll
        for (int r = 0; r < RR; ++r) { const int row = row0 + r; hr[r] = h_row(p, row); src[r] = hr[r]; xr[r] = xn + (size_t)row * DM; yy[r] = y + (size_t)row * DM; }
        row_step<RR>(yy, gy, hr, src, gx, xr, true, make_xn, lane);
    }
}

namespace att {
constexpr int KS_SB = 144, KS_ML = 208, VS = 144;
constexpr int KB0 = 0, KBSZ = 64 * KS_ML, VB0 = 2 * KBSZ, VBSZ = 64 * VS, FLG = VB0 + 2 * VBSZ;
__device__ __forceinline__ int pi_row(int m) { return 16 * (m >> 4) + 8 * ((m >> 2) & 1) + 4 * ((m >> 3) & 1) + (m & 3); }
#define MFMA32(a, b, c) __builtin_amdgcn_mfma_f32_32x32x16_bf16(a, b, c, 0, 0, 0)
__device__ __forceinline__ bf16x8 pack8(const f32x16& s, int o) {
    u32x4 w; w.x = pk_bf16(s[o + 0], s[o + 1]); w.y = pk_bf16(s[o + 2], s[o + 3]); w.z = pk_bf16(s[o + 4], s[o + 5]); w.w = pk_bf16(s[o + 6], s[o + 7]);
    return __builtin_bit_cast(bf16x8, w);
}
__device__ __forceinline__ void store_o(const f32x16& o0, const f32x16& o1, float inv, bf16_t* orow, float* ssrow, int hi, bool valid) {
    float ssq = 0.f;
#pragma unroll
    for (int db = 0; db < 2; ++db)
#pragma unroll
        for (int a = 0; a < 4; ++a) {
            const f32x16& o = db ? o1 : o0;
            const float v0 = o[4 * a] * inv, v1 = o[4 * a + 1] * inv, v2 = o[4 * a + 2] * inv, v3 = o[4 * a + 3] * inv;
            ssq += (v0 * v0 + v1 * v1) + (v2 * v2 + v3 * v3);
            if (valid) *(u32x2*)(orow + 32 * db + 8 * a + 4 * hi) = (u32x2){pk_bf16(v0, v1), pk_bf16(v2, v3)};
        }
    ssq += __shfl_xor(ssq, 32);
    if (valid && hi == 0) *ssrow = ssq;
}

__device__ __forceinline__ void mla_unit(int wave_s, LAS unsigned char* lds, const bf16_t* Q, const bf16_t* Kn, const bf16_t* Kr, const bf16_t* VT, bf16_t* O, float* ss, int b, int h, int qb) {
    int tid_ = phase_tid(wave_s);
    const int tid = tid_, lane = tid & 63, w = __builtin_amdgcn_readfirstlane(tid >> 6), ql = lane & 31, hi = lane >> 5;
    const bool meta = qb < 0;
    const int qrow = meta ? (TREAL + b * 16 + (ql & 15)) : (b * SEQ + qb * 256 + w * 32 + ql);
    const int qt = meta ? ql : (qb * 256 + w * 32 + ql);
    bf16x8 qf[6];
#pragma unroll
    for (int ks = 0; ks < 6; ++ks) qf[ks] = *(const bf16x8*)(Q + (size_t)qrow * 768 + h * 96 + (2 * ks + hi) * 8);
    const int ntiles = meta ? 1 : 4 * qb + 5;
    const int wlast = meta ? (w == 0 ? 0 : -1) : 1 + 4 * qb + (w >> 1);
    const int krow = tid >> 3, kch = tid & 7, rrow = tid >> 2, rch = tid & 3;
    const unsigned aoff = (unsigned)(pi_row(ql) * KS_ML + hi * 16), voff = (unsigned)(ql * VS + hi * 16);
    float mrun = -INFINITY, lrun = 0.f;
    f32x16 o0, o1;
#pragma unroll
    for (int i = 0; i < 16; ++i) { o0[i] = 0.f; o1[i] = 0.f; }
    struct TR { u32x4 k, r, v; };
    TR RA, RB; RA.r = (u32x4){0u, 0u, 0u, 0u}; RB.r = RA.r;
    auto gload = [&](TR& t, int i) {
        const int row0 = (i == 0) ? TREAL + b * 16 : b * SEQ + 64 * (i - 1);
        t.k = *(const u32x4*)(Kn + (size_t)(row0 + krow) * 512 + h * 64 + kch * 8);
        if (tid < 256) t.r = *(const u32x4*)(Kr + (size_t)(row0 + rrow) * 32 + rch * 8);
        t.v = *(const u32x4*)(VT + (size_t)(h * 64 + krow) * MP + row0 + kch * 8);
    };
    auto lstore = [&](const TR& t, int buf) {
        *(LAS u32x4*)(lds + KB0 + buf * KBSZ + krow * KS_ML + kch * 16) = t.k;
        if (tid < 256) *(LAS u32x4*)(lds + KB0 + buf * KBSZ + rrow * KS_ML + 128 + rch * 16) = t.r;
        *(LAS u32x4*)(lds + VB0 + buf * VBSZ + krow * VS + kch * 16) = t.v;
    };
    auto step = [&](int i, TR& X, TR& Y) {
        const int buf = i & 1;
        if (i + 2 < ntiles) gload(Y, i + 2);
        if (i <= wlast) {
            const LAS unsigned char* kb = lds + KB0 + buf * KBSZ + aoff; const LAS unsigned char* vb = lds + VB0 + buf * VBSZ + voff;
            f32x16 s0, s1;
#pragma unroll
            for (int r = 0; r < 16; ++r) { s0[r] = 0.f; s1[r] = 0.f; }
#pragma unroll
            for (int ks = 0; ks < 6; ++ks) {
                const bf16x8 a0 = *(const LAS bf16x8*)(kb + ks * 32), a1 = *(const LAS bf16x8*)(kb + 32 * KS_ML + ks * 32);
                s0 = MFMA32(a0, qf[ks], s0); s1 = MFMA32(a1, qf[ks], s1);
            }
            const int lim = (i == 0) ? (meta ? (ql < 15 ? ql : 15) : 15) : qt - 64 * (i - 1);
            if (__ballot(lim < 63) != 0ull) {
#pragma unroll
                for (int r = 0; r < 16; ++r) { const int ki = 16 * (r >> 3) + 8 * hi + (r & 7); if (ki > lim) s0[r] = -INFINITY; if (ki + 32 > lim) s1[r] = -INFINITY; }
            }
            float mx = fmaxf(s0[0], s1[0]);
#pragma unroll
            for (int r = 1; r < 16; ++r) mx = fmaxf(mx, fmaxf(s0[r], s1[r]));
            mx = fmaxf(mx, __shfl_xor(mx, 32));
            const float mn = fmaxf(mrun, mx);
            if (__ballot(mn > mrun) != 0ull) {
                const float alpha = __builtin_amdgcn_exp2f(mrun - mn); lrun *= alpha;
#pragma unroll
                for (int r = 0; r < 16; ++r) { o0[r] *= alpha; o1[r] *= alpha; }
            }
            mrun = mn;
            float rs = 0.f;
#pragma unroll
            for (int r = 0; r < 16; ++r) { s0[r] = __builtin_amdgcn_exp2f(s0[r] - mn); s1[r] = __builtin_amdgcn_exp2f(s1[r] - mn); rs += s0[r] + s1[r]; }
            lrun += rs;
#pragma unroll
            for (int s = 0; s < 4; ++s) {
                const bf16x8 pf = pack8((s >> 1) ? s1 : s0, 8 * (s & 1));
                const bf16x8 v0 = *(const LAS bf16x8*)(vb + s * 32), v1 = *(const LAS bf16x8*)(vb + 32 * VS + s * 32);
                o0 = MFMA32(v0, pf, o0); o1 = MFMA32(v1, pf, o1);
            }
        }
        if (i + 1 < ntiles) lstore(X, buf ^ 1);
        __syncthreads();
    };
    gload(RB, 0); lstore(RB, 0); if (ntiles > 1) gload(RA, 1); __syncthreads();
    for (int i = 0; i < ntiles; i += 2) { step(i, RA, RB); if (i + 1 < ntiles) step(i + 1, RB, RA); }
    lrun += __shfl_xor(lrun, 32);
    const bool valid = meta ? (w == 0 && ql < 16) : true;
    store_o(o0, o1, 1.0f / lrun, O + (size_t)qrow * 1024 + 512 + h * 64, ss + (size_t)qrow * 16 + 8 + h, hi, valid);
}

__device__ __forceinline__ void sb_unit(int wave_s, LAS unsigned char* lds, const bf16_t* QK, const bf16_t* VT, bf16_t* O, float* ss, int b, int h, int qb) {
    int tid_ = phase_tid(wave_s);
    const int tid = tid_, lane = tid & 63, w = __builtin_amdgcn_readfirstlane(tid >> 6), ql = lane & 31, hi = lane >> 5;
    const bool meta = qb < 0;
    const int qrow = meta ? (TREAL + b * 16 + (ql & 15)) : (b * SEQ + qb * 256 + w * 32 + ql);
    const int qt = meta ? ql : (qb * 256 + w * 32 + ql);
    bf16x8 qf[4];
#pragma unroll
    for (int ks = 0; ks < 4; ++ks) qf[ks] = *(const bf16x8*)(QK + (size_t)qrow * 1024 + h * 64 + (2 * ks + hi) * 8);
    const int ntiles = meta ? 1 : 4 * qb + 5;
    const int wfirst = meta ? (w == 0 ? 0 : 1) : 3 - (w >> 1);
    const int krow = tid >> 3, kch = tid & 7;
    const unsigned aoff = (unsigned)(pi_row(ql) * KS_SB + hi * 16), voff = (unsigned)(ql * VS + hi * 16);
    f32x16 o0, o1;
#pragma unroll
    for (int i = 0; i < 16; ++i) { o0[i] = 0.f; o1[i] = 0.f; }
    float carry = 0.f;
    struct TR { u32x4 k, v; };
    TR RA, RB;
    auto gload = [&](TR& t, int i) {
        const int row0 = (meta || i == ntiles - 1) ? TREAL + b * 16 : b * SEQ + 64 * (4 * qb + 3 - i);
        t.k = *(const u32x4*)(QK + (size_t)(row0 + krow) * 1024 + 512 + h * 64 + kch * 8);
        t.v = *(const u32x4*)(VT + (size_t)(h * 64 + krow) * MP + row0 + kch * 8);
    };
    auto lstore = [&](const TR& t, int buf) {
        *(LAS u32x4*)(lds + KB0 + buf * KBSZ + krow * KS_SB + kch * 16) = t.k;
        *(LAS u32x4*)(lds + VB0 + buf * VBSZ + krow * VS + kch * 16) = t.v;
    };
    LAS int* flg = (LAS int*)(lds + FLG);
    auto step = [&](int i, TR& X, TR& Y) -> bool {
        const int buf = i & 1;
        if (i > 0) {
            int all = 1;
#pragma unroll
            for (int k = 0; k < NWAVE; ++k) all &= flg[(buf ^ 1) * NWAVE + k];
            if (all) return true;
        }
        if (i + 2 < ntiles) gload(Y, i + 2);
        if (i >= wfirst) {
            const LAS unsigned char* kb = lds + KB0 + buf * KBSZ + aoff; const LAS unsigned char* vb = lds + VB0 + buf * VBSZ + voff;
            f32x16 s0, s1, l0, l1;
#pragma unroll
            for (int r = 0; r < 16; ++r) { s0[r] = 0.f; s1[r] = 0.f; }
#pragma unroll
            for (int ks = 0; ks < 4; ++ks) {
                const bf16x8 a0 = *(const LAS bf16x8*)(kb + ks * 32), a1 = *(const LAS bf16x8*)(kb + 32 * KS_SB + ks * 32);
                s0 = MFMA32(a0, qf[ks], s0); s1 = MFMA32(a1, qf[ks], s1);
            }
            const bool mtile = meta || i == ntiles - 1;
            const int lim = mtile ? (meta ? (ql < 16 ? ql - 1 : 15) : 15) : qt - 64 * (4 * qb + 3 - i) - 1;
#pragma unroll
            for (int r = 0; r < 16; ++r) {
                const int ki = 16 * (r >> 3) + 8 * hi + (r & 7);
                { const float z = s0[r], sp = fmaxf(z, 0.f) + 0.69314718056f * __builtin_amdgcn_logf(1.f + __builtin_amdgcn_exp2f(-1.44269504089f * fabsf(z))); const bool ok = ki <= lim; l0[r] = ok ? -sp : 0.f; s0[r] = ok ? z : -INFINITY; }
                { const float z = s1[r], sp = fmaxf(z, 0.f) + 0.69314718056f * __builtin_amdgcn_logf(1.f + __builtin_amdgcn_exp2f(-1.44269504089f * fabsf(z))); const bool ok = ki + 32 <= lim; l1[r] = ok ? -sp : 0.f; s1[r] = ok ? z : -INFINITY; }
            }
            float og[4], pg[4];
#pragma unroll
            for (int q = 0; q < 4; ++q) { const f32x16& l = (q >> 1) ? l1 : l0; const int o = 8 * (q & 1);
                og[q] = ((l[o] + l[o + 1]) + (l[o + 2] + l[o + 3])) + ((l[o + 4] + l[o + 5]) + (l[o + 6] + l[o + 7])); pg[q] = __shfl_xor(og[q], 32); }
            float tail = carry;
#pragma unroll
            for (int q = 3; q >= 0; --q) {
                f32x16& l = (q >> 1) ? l1 : l0; f32x16& s = (q >> 1) ? s1 : s0; const int o = 8 * (q & 1);
                float run = tail + (hi == 0 ? pg[q] : 0.f);
#pragma unroll
                for (int j = 7; j >= 0; --j) { const float lm = l[o + j]; s[o + j] = __builtin_amdgcn_exp2f(1.44269504089f * (s[o + j] + lm + run)); run += lm; }
                tail += og[q] + pg[q];
            }
            carry = tail;
#pragma unroll
            for (int s = 0; s < 4; ++s) {
                const bf16x8 pf = pack8((s >> 1) ? s1 : s0, 8 * (s & 1));
                const bf16x8 v0 = *(const LAS bf16x8*)(vb + s * 32), v1 = *(const LAS bf16x8*)(vb + 32 * VS + s * 32);
                o0 = MFMA32(v0, pf, o0); o1 = MFMA32(v1, pf, o1);
            }
        }
        { const int dn = (__ballot(carry >= -104.0f) == 0ull) ? 1 : 0; if (lane == 0) flg[buf * NWAVE + w] = dn; }
        if (i + 1 < ntiles) lstore(X, buf ^ 1);
        __syncthreads();
        return false;
    };
    gload(RB, 0); lstore(RB, 0); if (ntiles > 1) gload(RA, 1); __syncthreads();
    for (int i = 0; i < ntiles; i += 2) { if (step(i, RA, RB)) break; if (i + 1 < ntiles) { if (step(i + 1, RB, RA)) break; } }
    __syncthreads();
    const bool valid = meta ? (w == 0 && ql < 16) : true;
    store_o(o0, o1, 1.0f, O + (size_t)qrow * 1024 + h * 64, ss + (size_t)qrow * 16 + h, hi, valid);
}

__device__ __forceinline__ void phase_attention(const Params& p, LAS unsigned char* lds, int layer, int wave_s) {
    unsigned char* g = p.ws + WS_G;
    const bf16_t* QK = (const bf16_t*)(g + G_QK); const bf16_t* VTS = (const bf16_t*)(g + G_VTS);
    const bf16_t* QM = (const bf16_t*)(g + G_QM); const bf16_t* KN = (const bf16_t*)(g + G_KN); const bf16_t* KR = (const bf16_t*)(g + G_KR); const bf16_t* VTM = (const bf16_t*)(g + G_VTM);
    bf16_t* O = (bf16_t*)(g + G_O);
    float* ss_sb = (float*)(p.ws + WS_SS) + (size_t)layer * 48 * MP + (size_t)32 * MP; float* ss_ml = ss_sb;
    const int nunits = layer == 1 ? 2048 : 2176;
    for (int idx = blockIdx.x; idx < nunits; idx += gridDim.x) {
        if (idx < 1024) {
            const int rnd = idx >> 8, cc = idx & 255, grp = cc >> 6, bh = cc & 63;
            const int qb = rnd == 0 ? 15 - grp : rnd == 1 ? 8 + grp : rnd == 2 ? 7 - grp : grp;
            mla_unit(wave_s, lds, QM, KN, KR, VTM, O, ss_ml, bh >> 3, bh & 7, qb);
        } else if (idx < 2048) {
            const int k = idx - 1024, bh = k & 63, qb = k >> 6;
            sb_unit(wave_s, lds, QK, VTS, O, ss_sb, bh >> 3, bh & 7, qb);
        } else if (idx < 2112) { const int bh = idx - 2048; mla_unit(wave_s, lds, QM, KN, KR, VTM, O, ss_ml, bh >> 3, bh & 7, -1); }
        else { const int bh = idx - 2112; sb_unit(wave_s, lds, QK, VTS, O, ss_sb, bh >> 3, bh & 7, -1); }
    }
}
}


__device__ __forceinline__ void grid_barrier(unsigned* cnt, unsigned target) {
    asm volatile("s_waitcnt vmcnt(0) lgkmcnt(0)" ::: "memory");
    __syncthreads();
    if (threadIdx.x == 0) {
        __builtin_amdgcn_fence(__ATOMIC_RELEASE, "agent");
        asm volatile("s_waitcnt vmcnt(0)" ::: "memory");
        __hip_atomic_fetch_add(cnt, 1u, __ATOMIC_RELAXED, __HIP_MEMORY_SCOPE_AGENT);
        while (__hip_atomic_load(cnt, __ATOMIC_RELAXED, __HIP_MEMORY_SCOPE_AGENT) < target) __builtin_amdgcn_s_sleep(1);
        __builtin_amdgcn_fence(__ATOMIC_ACQUIRE, "agent");
        asm volatile("s_waitcnt vmcnt(0)" ::: "memory");
    }
    __syncthreads();
}

__global__ void __launch_bounds__(NTHR) hybrid_fwd(Params p) {
    extern __shared__ __attribute__((aligned(16))) unsigned char smem[];
    LAS unsigned char* lds = (LAS unsigned char*)smem;
    cg::grid_group grid = cg::this_grid();
    const int wave_s = __builtin_amdgcn_readfirstlane((int)threadIdx.x >> 6);
    unsigned char* ws = p.ws; unsigned char* g = ws + WS_G;
    const float* cosT = (const float*)(ws + WS_ROPE); const float* sinT = cosT + LPOS * 16;
    bf16_t* xn = (bf16_t*)(ws + WS_XN);
    const int lo = p.ph_lo, hi = p.ph_hi;
    int ph = 0, nbar = 0;
    unsigned* bar_cnt = (unsigned*)(ws + WS_HMETA + 200ull * 1024 * 4);
    if (blockIdx.x == 0 && threadIdx.x == 0) __hip_atomic_store(bar_cnt, 0u, __ATOMIC_RELAXED, __HIP_MEMORY_SCOPE_AGENT);
#ifndef PHMASK
#define PHMASK 0xFFFFFFFFu
#endif
#define PHASE_BEGIN if (ph >= lo && ph < hi) {
#define PHASE_END   if (ph + 1 < hi) { if (ph == lo) grid.sync(); else grid_barrier(bar_cnt, (unsigned)(++nbar) * gridDim.x); } } ++ph;

    PHASE_BEGIN if (PHMASK & 1u) phase_prologue(p, lds, wave_s); PHASE_END
    for (int layer = 0; layer < 2; ++layer) {
        unsigned char* wl = ws + WS_W + (size_t)layer * W_LAYER;
        float* ss_c = (float*)(ws + WS_SS) + (size_t)layer * 48 * MP; float* ss_o = ss_c + (size_t)32 * MP;
        const int Mrows = layer == 1 ? TREAL : MP, nrows = layer == 1 ? TREAL : TTOT;
        PHASE_BEGIN if (PHMASK & 2u) {
            epi::Main E{(bf16_t*)(g + G_QK), (bf16_t*)(g + G_CQ), (bf16_t*)(g + G_CKV), (bf16_t*)(g + G_KR), ss_c, cosT, sinT};
#ifndef NO_A
            run_gemm(lds, xn, 1024, (const bf16_t*)(wl + W_MAIN), 1024, MP, NMAIN, 1024, -1, 0, E, wave_s);
#endif
            epi::Bf16R EV{(bf16_t*)(g + G_VTS), MP, nullptr, 0.f};
#ifndef NO_B
            run_gemm(lds, (const bf16_t*)(wl + W_V), 1024, xn, 1024, 512, MP, 1024, -1, 136, EV, wave_s);
#endif
 }
        PHASE_END
        PHASE_BEGIN if (PHMASK & 4u) {
            epi::QMla EQ{(bf16_t*)(g + G_QM), ss_c, cosT, sinT};
#ifndef NO_A
            run_gemm(lds, (const bf16_t*)(g + G_CQ), 384, (const bf16_t*)(wl + W_UQ), 384, MP, 768, 384, -1, 0, EQ, wave_s);
#endif
            epi::Bf16R EK{(bf16_t*)(g + G_KN), 512, ss_c + 16, 1.f / KVLORA};
#ifndef NO_B
            run_gemm(lds, (const bf16_t*)(g + G_CKV), 256, (const bf16_t*)(wl + W_UK), 256, MP, 512, 256, -1, 128, EK, wave_s);
#endif
            epi::Bf16C EV{(bf16_t*)(g + G_VTM), MP, ss_c + 16, 1.f / KVLORA};
#ifndef NO_C
            run_gemm(lds, (const bf16_t*)(wl + W_UV), 256, (const bf16_t*)(g + G_CKV), 256, 512, MP, 256, -1, 136, EV, wave_s);
#endif
 }
        PHASE_END
        PHASE_BEGIN if (PHMASK & 8u) att::phase_attention(p, lds, layer, wave_s); PHASE_END
        PHASE_BEGIN if (PHMASK & 16u) {
            epi::Wo E{(bf16_t*)(g + G_MIX), ss_o};
            run_gemm(lds, (const bf16_t*)(g + G_O), 1024, (const bf16_t*)(wl + W_O), 1024, Mrows, 1024, 1024, 8, 0, E, wave_s); }
        PHASE_END
        PHASE_BEGIN if (PHMASK & 32u) phase_rows(p, (const bf16_t*)(g + G_MIX), p.in[11] + layer * DM, p.in[12] + layer * DM, true, nrows, wave_s); PHASE_END
        PHASE_BEGIN if (PHMASK & 64u) {
            epi::GateUp E{(bf16_t*)(g + G_ACT)};
            run_gemm(lds, xn, 1024, (const bf16_t*)(wl + W_GU), 1024, Mrows, NGU, 1024, -1, 0, E, wave_s); }
        PHASE_END
        PHASE_BEGIN if (PHMASK & 128u) {
            epi::F32Out E{(bf16_t*)(g + G_FFN)};
            run_gemm(lds, (const bf16_t*)(g + G_ACT), DFF, (const bf16_t*)(wl + W_D), DFF, Mrows, 1024, DFF, -1, 0, E, wave_s); }
        PHASE_END
        PHASE_BEGIN if (PHMASK & 256u) phase_rows(p, (const bf16_t*)(g + G_FFN), p.in[13] + layer * DM, p.in[10] + (layer < 1 ? (layer + 1) * DM : 0), layer < 1, nrows, wave_s); PHASE_END
    }
}
constexpr int N_PHASES = 17;

#ifdef DBG_STOP
__global__ void __launch_bounds__(256) dbg_dump(Params p) {
    unsigned char* g = p.ws + WS_G;
    const size_t n = (size_t)TREAL * DM;
    for (size_t i = (size_t)blockIdx.x * 256 + threadIdx.x; i < n; i += (size_t)gridDim.x * 256) {
        const size_t row = i >> 10, c = i & 1023; float v = 0.f;
        auto bf = [](const unsigned char* b, size_t idx) { return __uint_as_float((unsigned)((const bf16_t*)b)[idx] << 16); };
#if DBG_DUMP == 1
        v = bf(g + G_QK, row * 1024 + c) + bf(g + G_CQ, row * 384 + c % 384) + bf(g + G_CKV, row * 256 + c % 256) + bf(g + G_KR, row * 32 + c % 32) + bf(g + G_VTS, (c % 512) * MP + row)
          + ((const float*)(p.ws + WS_SS))[row] + ((const float*)(p.ws + WS_SS))[MP + row];
#elif DBG_DUMP == 2
        v = bf(g + G_QM, row * 768 + c % 768) + bf(g + G_KN, row * 512 + c % 512) + bf(g + G_VTM, (c % 512) * MP + row);
#elif DBG_DUMP == 3
        v = bf(g + G_O, row * 1024 + c);
#elif DBG_DUMP == 31
        v = c < 512 ? bf(g + G_O, row * 1024 + c) : 0.f;
#elif DBG_DUMP == 32
        v = c >= 512 ? bf(g + G_O, row * 1024 + c) : 0.f;
#elif DBG_DUMP == 4
        v = ((const float*)(g + G_MIX))[row * 1024 + c];
#elif DBG_DUMP == 5
        v = bf(p.ws + WS_XN, row * 1024 + c);
#elif DBG_DUMP == 6
        v = bf(g + G_ACT, row * DFF + c) + bf(g + G_ACT, row * DFF + 1024 + c) + bf(g + G_ACT, row * DFF + 1792 + c);
#elif DBG_DUMP == 7
        v = ((const float*)(g + G_FFN))[row * 1024 + c];
#endif
#ifdef DBG_SAN
        if (!(fabsf(v) < 1e30f)) v = 12345.f;
#endif
        p.out[i] = v;
    }
}
#endif

extern "C" void kernel_launch(void* const* d_in, const int* in_sizes, int n_in, void* d_out, int out_size, void* d_ws, size_t ws_size, hipStream_t stream) {
    static int grid = 0;
    if (grid == 0) {
        if (n_in != 17 || ws_size < WS_END) { fprintf(stderr, "kernel_launch: need 17 inputs and %zu bytes of workspace (got %d, %zu)\n", (size_t)WS_END, n_in, ws_size); grid = -1; return; }
        int dev = 0, cus = 0, per_cu = 0;
        (void)hipGetDevice(&dev); (void)hipDeviceGetAttribute(&cus, hipDeviceAttributeMultiprocessorCount, dev);
        (void)hipFuncSetAttribute((const void*)hybrid_fwd, hipFuncAttributeMaxDynamicSharedMemorySize, LDS_BYTES);
        (void)hipOccupancyMaxActiveBlocksPerMultiprocessor(&per_cu, (const void*)hybrid_fwd, NTHR, LDS_BYTES);
        if (per_cu < 1) { fprintf(stderr, "kernel_launch: occupancy query says %d blocks per CU\n", per_cu); per_cu = 1; }
        (void)hipGetLastError();
        grid = cus * 1;
    }
    if (grid < 0) return;
    Params p; memset(&p, 0, sizeof(p));
    for (int i = 0; i < 17; ++i) p.in[i] = (const float*)d_in[i];
    p.out = (float*)d_out; p.ws = (unsigned char*)d_ws;
    for (int i = 0; i < 16; ++i) p.inv_freq[i] = 1.0f / powf(10000.0f, (float)(2 * i) / 32.0f);
#ifndef MK_LAUNCHES
#define MK_LAUNCHES 1
#endif
    if (MK_LAUNCHES == 1) {
        p.ph_lo = 0; p.ph_hi = N_PHASES;
        void* args[] = {&p};
        hipError_t e = hipLaunchCooperativeKernel((const void*)hybrid_fwd, dim3(grid), dim3(NTHR), args, LDS_BYTES, stream);
        if (e != hipSuccess) fprintf(stderr, "cooperative launch failed: %s (grid %d)\n", hipGetErrorString(e), grid);
    } else {
#ifdef DBG_STOP
        for (int k = 0; k < DBG_STOP; ++k) { p.ph_lo = k; p.ph_hi = k + 1; hipLaunchKernelGGL(hybrid_fwd, dim3(grid), dim3(NTHR), LDS_BYTES, stream, p); }
        hipLaunchKernelGGL(dbg_dump, dim3(2048), dim3(256), 0, stream, p);
#else
        for (int k = 0; k < N_PHASES; ++k) { p.ph_lo = k; p.ph_hi = k + 1; hipLaunchKernelGGL(hybrid_fwd, dim3(grid), dim3(NTHR), LDS_BYTES, stream, p); }
#endif
    }
}
```
